# Optimizing an MI355X kernel written in HIP

```python
import jax, jax.numpy as jnp
from jax import lax
import numpy as np

D_MODEL = 2048
BATCH = 4
SEQ = 4096
DEPTH = 2

MEM_LEN = 256
EPS = 1e-6
N_BRANCH = 3
BRANCH_WIDTH = 1024

CHUNK = 128
A_GROUPS = 8
A_GROUP_DIM = 128
A_WIDTH = A_GROUPS * A_GROUP_DIM

WINDOW = 128
BLOCK = 128
B_HEADS = 16
B_KV_HEADS = 4
B_HEAD_DIM = 64
B_Q_WIDTH = B_HEADS * B_HEAD_DIM
B_KV_WIDTH = B_KV_HEADS * B_HEAD_DIM

C_HEADS = 4
C_HEAD_DIM = 256
C_WIDTH = C_HEADS * C_HEAD_DIM

SPLIT_POINTS = (
    A_WIDTH,
    2 * A_WIDTH,
    2 * A_WIDTH + B_Q_WIDTH,
    2 * A_WIDTH + B_Q_WIDTH + B_KV_WIDTH,
    2 * A_WIDTH + B_Q_WIDTH + 2 * B_KV_WIDTH,
    2 * A_WIDTH + B_Q_WIDTH + 2 * B_KV_WIDTH + C_WIDTH,
)
IN_WIDTH = 2 * A_WIDTH + B_Q_WIDTH + 2 * B_KV_WIDTH + C_WIDTH + N_BRANCH * D_MODEL

N_GROUPS = 4
EXPERTS_PER_GROUP = 4
N_EXPERTS = N_GROUPS * EXPERTS_PER_GROUP
TOP_K = 2
D_FF_EXPERT = 512

kernel_name = "hybrid_gmlp_swa_sink_memxattn_hmoe"


def rms_norm(x, gain):
    xf = x.astype(jnp.float32)
    y = xf * lax.rsqrt(jnp.mean(xf * xf, axis=-1, keepdims=True) + EPS)
    return (y * gain.astype(jnp.float32)).astype(x.dtype)


def chunked_spatial_gating(u, v, v_gain, w_s, b_s):
    b, s, _ = u.shape
    n = s // CHUNK
    v = rms_norm(v.reshape(b, n, CHUNK, A_GROUPS, A_GROUP_DIM), v_gain)
    causal = jnp.tril(jnp.ones((CHUNK, CHUNK), dtype=bool))
    w = jnp.where(causal[None], w_s, 0.0).astype(v.dtype)
    mixed = jnp.einsum('gts,bnsgc->bntgc', w, v) + b_s.T[:, :, None].astype(v.dtype)
    out = u.reshape(b, n, CHUNK, A_GROUPS, A_GROUP_DIM) * mixed
    return out.reshape(b, s, A_WIDTH)


def sliding_window_sink_attention(q, k, v, sinks):
    b, s, _, _ = q.shape
    n = s // BLOCK
    rep = B_HEADS // B_KV_HEADS
    qb = q.reshape(b, n, BLOCK, B_KV_HEADS, rep, B_HEAD_DIM)
    kb = k.reshape(b, n, BLOCK, B_KV_HEADS, B_HEAD_DIM)
    vb = v.reshape(b, n, BLOCK, B_KV_HEADS, B_HEAD_DIM)

    def with_prev(t):
        prev = jnp.pad(t[:, :-1], ((0, 0), (1, 0), (0, 0), (0, 0), (0, 0)))
        return jnp.concatenate([prev, t], axis=2)

    kw, vw = with_prev(kb), with_prev(vb)
    scores = jnp.einsum('bnqkrd,bnskd->bnkrqs', qb, kw,
                        preferred_element_type=jnp.float32) * (B_HEAD_DIM ** -0.5)
    n_idx = jnp.arange(n)[:, None, None]
    qi = jnp.arange(BLOCK)[None, :, None]
    kj = jnp.arange(2 * BLOCK)[None, None, :]
    rel = BLOCK + qi - kj
    mask = (rel >= 0) & (rel < WINDOW) & ((n_idx > 0) | (kj >= BLOCK))
    scores = jnp.where(mask[None, :, None, None], scores, -jnp.inf)
    sink = sinks.astype(jnp.float32).reshape(1, 1, B_KV_HEADS, rep, 1, 1)
    m = jnp.maximum(jnp.max(scores, axis=-1, keepdims=True), sink)
    p = jnp.exp(scores - m)
    denom = jnp.sum(p, axis=-1, keepdims=True) + jnp.exp(sink - m)
    probs = (p / denom).astype(v.dtype)
    out = jnp.einsum('bnkrqs,bnskd->bnqkrd', probs, vw)
    return out.reshape(b, s, B_Q_WIDTH)


def memory_cross_attention(q, k, v):
    b, s, _, _ = q.shape
    scores = jnp.einsum('bshd,bmhd->bhsm', q, k,
                        preferred_element_type=jnp.float32) * (C_HEAD_DIM ** -0.5)
    probs = jax.nn.softmax(scores, axis=-1).astype(v.dtype)
    return jnp.einsum('bhsm,bmhd->bshd', probs, v).reshape(b, s, C_WIDTH)


def hierarchical_moe(h, w_rg, b_rg, w_re, b_re, w_gate, w_up, w_down):
    b, s, d = h.shape
    t = h.reshape(b * s, d)
    group_logits = (t @ w_rg).astype(jnp.float32) + b_rg.astype(jnp.float32)
    group_probs = jax.nn.softmax(group_logits, axis=-1)
    g = jnp.argmax(group_logits, axis=-1)
    p_g = jnp.take_along_axis(group_probs, g[:, None], axis=-1)
    expert_logits = ((t @ w_re).astype(jnp.float32) + b_re.astype(jnp.float32)
                     ).reshape(-1, N_GROUPS, EXPERTS_PER_GROUP)
    in_group = jnp.take_along_axis(expert_logits, g[:, None, None], axis=1)[:, 0]
    top_vals, top_idx = lax.top_k(in_group, TOP_K)
    weights = jax.nn.softmax(top_vals, axis=-1) * p_g
    expert_id = g[:, None] * EXPERTS_PER_GROUP + top_idx
    gates = jnp.sum(jax.nn.one_hot(expert_id, N_EXPERTS, dtype=jnp.float32)
                    * weights[..., None], axis=1)
    hidden = (jax.nn.silu(jnp.einsum('td,edf->tef', t, w_gate))
              * jnp.einsum('td,edf->tef', t, w_up))
    hidden = hidden * gates[..., None].astype(hidden.dtype)
    out = jnp.einsum('tef,efd->td', hidden, w_down)
    return out.reshape(b, s, d)


def setup_inputs(seed: int = 0) -> dict:
    key = jax.random.key(seed)
    ks = jax.random.split(key, 26)

    def nrm(k, shape, scale):
        return jax.random.normal(k, shape, dtype=jnp.float32) * scale

    def gain(k, shape):
        return 1.0 + 0.05 * jax.random.normal(k, shape, dtype=jnp.float32)

    L = DEPTH
    return {
        "x": nrm(ks[0], (BATCH, SEQ, D_MODEL), 1.0),
        "mem": nrm(ks[1], (BATCH, MEM_LEN, D_MODEL), 1.0),
        "norm_mix": gain(ks[2], (L, D_MODEL)),
        "norm_mem": gain(ks[3], (L, D_MODEL)),
        "norm_ffn": gain(ks[4], (L, D_MODEL)),
        "w_in": nrm(ks[5], (L, D_MODEL, IN_WIDTH), D_MODEL ** -0.5),
        "v_gain": gain(ks[6], (L, A_GROUPS, A_GROUP_DIM)),
        "w_spatial": nrm(ks[7], (L, A_GROUPS, CHUNK, CHUNK), CHUNK ** -0.5),
        "b_spatial": 1.0 + 0.02 * jax.random.normal(ks[8], (L, A_GROUPS, CHUNK), dtype=jnp.float32),
        "q_gain_b": gain(ks[9], (L, B_HEAD_DIM)),
        "k_gain_b": gain(ks[10], (L, B_HEAD_DIM)),
        "sinks": nrm(ks[11], (L, B_HEADS), 0.5),
        "q_gain_c": gain(ks[12], (L, C_HEAD_DIM)),
        "k_gain_c": gain(ks[13], (L, C_HEAD_DIM)),
        "w_mem_kv": nrm(ks[14], (L, D_MODEL, 2 * C_WIDTH), D_MODEL ** -0.5),
        "w_branch": nrm(ks[15], (L, N_BRANCH, BRANCH_WIDTH, D_MODEL), BRANCH_WIDTH ** -0.5),
        "w_out": nrm(ks[16], (L, D_MODEL, D_MODEL), D_MODEL ** -0.5),
        "w_router_group": nrm(ks[17], (L, D_MODEL, N_GROUPS), D_MODEL ** -0.5),
        "b_router_group": nrm(ks[18], (L, N_GROUPS), 0.01),
        "w_router_expert": nrm(ks[19], (L, D_MODEL, N_EXPERTS), D_MODEL ** -0.5),
        "b_router_expert": nrm(ks[20], (L, N_EXPERTS), 0.01),
        "w_gate_e": nrm(ks[21], (L, N_EXPERTS, D_MODEL, D_FF_EXPERT), D_MODEL ** -0.5),
        "w_up_e": nrm(ks[22], (L, N_EXPERTS, D_MODEL, D_FF_EXPERT), D_MODEL ** -0.5),
        "w_down_e": nrm(ks[23], (L, N_EXPERTS, D_FF_EXPERT, D_MODEL), D_FF_EXPERT ** -0.5),
    }


def reference(x, mem, norm_mix, norm_mem, norm_ffn, w_in, v_gain, w_spatial, b_spatial,
              q_gain_b, k_gain_b, sinks, q_gain_c, k_gain_c, w_mem_kv, w_branch, w_out,
              w_router_group, b_router_group, w_router_expert, b_router_expert,
              w_gate_e, w_up_e, w_down_e):
    b, s, _ = x.shape
    m_len = mem.shape[1]
    for layer in range(DEPTH):
        h = rms_norm(x, norm_mix[layer])
        proj = h @ w_in[layer]
        u_a, v_a, q_b, k_b, v_b, q_c, gate_logits = jnp.split(proj, SPLIT_POINTS, axis=-1)

        y_a = chunked_spatial_gating(jax.nn.gelu(u_a, approximate=False),
                                     jax.nn.gelu(v_a, approximate=False),
                                     v_gain[layer], w_spatial[layer], b_spatial[layer])

        qb = rms_norm(q_b.reshape(b, s, B_HEADS, B_HEAD_DIM), q_gain_b[layer])
        kb = rms_norm(k_b.reshape(b, s, B_KV_HEADS, B_HEAD_DIM), k_gain_b[layer])
        vb = v_b.reshape(b, s, B_KV_HEADS, B_HEAD_DIM)
        y_b = sliding_window_sink_attention(qb, kb, vb, sinks[layer])

        mem_h = rms_norm(mem, norm_mem[layer])
        k_c, v_c = jnp.split(mem_h @ w_mem_kv[layer], 2, axis=-1)
        kc = rms_norm(k_c.reshape(b, m_len, C_HEADS, C_HEAD_DIM), k_gain_c[layer])
        vc = v_c.reshape(b, m_len, C_HEADS, C_HEAD_DIM)
        qc = rms_norm(q_c.reshape(b, s, C_HEADS, C_HEAD_DIM), q_gain_c[layer])
        y_c = memory_cross_attention(qc, kc, vc)

        branches = jnp.stack([y_a, y_b, y_c], axis=2)
        widened = jnp.einsum('bsnw,nwd->bsnd', branches, w_branch[layer])
        gates = jax.nn.sigmoid(gate_logits.reshape(b, s, N_BRANCH, D_MODEL))
        merged = jnp.sum(gates * widened, axis=2)
        x = x + merged @ w_out[layer]

        h2 = rms_norm(x, norm_ffn[layer])
        x = x + hierarchical_moe(h2, w_router_group[layer], b_router_group[layer],
                                 w_router_expert[layer], b_router_expert[layer],
                                 w_gate_e[layer], w_up_e[layer], w_down_e[layer])
    return x
```

```cpp
#include <hip/hip_runtime.h>
#include <cstdio>
#include <cstdint>
#include <type_traits>

#ifndef MEGA
#define MEGA 1
#endif
#ifndef FAST_GEMM
#define FAST_GEMM 0
#endif

#define GAS __attribute__((address_space(1)))
#define CAS __attribute__((address_space(4)))
#define LAS __attribute__((address_space(3)))
typedef unsigned short bf16;
typedef unsigned v4u __attribute__((ext_vector_type(4)));
typedef unsigned v2u __attribute__((ext_vector_type(2)));
typedef float f32x4 __attribute__((ext_vector_type(4)));
typedef float f32x2 __attribute__((ext_vector_type(2)));
typedef short bf16x8 __attribute__((ext_vector_type(8)));
typedef GAS unsigned gu32;
#define RLX_AGENT __ATOMIC_RELAXED, __HIP_MEMORY_SCOPE_AGENT
#define LDS_WAIT() asm volatile("s_waitcnt lgkmcnt(0)" ::: "memory")
#define VM_WAIT() asm volatile("s_waitcnt vmcnt(0)" ::: "memory")

constexpr int NB = 4, SEQ = 4096, T = NB * SEQ, D = 2048, NIN = 10752, MEML = 256, MEMT = NB * MEML, NLAYER = 2;
constexpr int NEXP = 16, DFF = 512;
constexpr int NBUCKET = 24;
constexpr int TPAD = T + NBUCKET * 256;
constexpr float EPS = 1e-6f;
constexpr int NWAVES = 8, NTHR = 512;

constexpr size_t MiB = 1u << 20;
constexpr size_t WS_CTL = 0, CTL_ZERO_BYTES = 1 * MiB;
constexpr size_t WS_WIN = 4 * MiB;
constexpr size_t WS_WMKV = 46 * MiB;
constexpr size_t WS_WBR = 54 * MiB;
constexpr size_t WS_WOUT = 66 * MiB;
constexpr size_t WS_WGU = 74 * MiB;
constexpr size_t WS_WD = 138 * MiB;
constexpr size_t WS_H = 170 * MiB;
constexpr size_t WS_MEMH = 234 * MiB;
constexpr size_t WS_KVM = 238 * MiB;
constexpr size_t WS_P1 = 242 * MiB;
constexpr size_t WS_P2 = 306 * MiB;
constexpr size_t WS_P3 = 354 * MiB;
constexpr size_t WS_P4 = 386 * MiB;
constexpr size_t WS_XB = 482 * MiB;
constexpr size_t WS_Y = 578 * MiB;
constexpr size_t WS_H8 = 674 * MiB;
constexpr size_t WS_WG8 = 12 * MiB;
constexpr size_t WS_PERM2 = 706 * MiB;
constexpr size_t WS_ROWW2 = 708 * MiB;
constexpr size_t WS_END = 718 * MiB;
constexpr size_t WS_MF = WS_P1;
constexpr size_t WS_HID = WS_Y;
static_assert(WS_MF + (size_t)T * D * 2 <= WS_P2 && WS_HID + (size_t)TPAD * 1024 * 2 <= WS_H8, "overlays");
static_assert(WS_P4 + (size_t)T * 6144 <= WS_XB && WS_XB + (size_t)T * D * 2 <= WS_Y, "residual stream region");
static_assert(WS_PERM2 + (size_t)NBUCKET * T * 4 <= WS_ROWW2 && WS_ROWW2 + (size_t)NBUCKET * T * 16 <= WS_END, "bucket tables");
constexpr int CW_BAR = 4096;
constexpr int CW_CNT = 16384;
constexpr int CW_WRT = 131072;
static_assert((CW_WRT + 20 * 2048) * 4 <= (1 << 20), "router table inside the control block");

constexpr int LDS_BYTES = 147456;
constexpr int LDS_CTL_OFF = 146432;
constexpr int LW_BAR = 0;
constexpr int LW_TSTART = 16;
constexpr int LW_CNT = 48;
constexpr int LW_NT = 80;

__device__ __forceinline__ unsigned f2bf(float f) { unsigned u = __builtin_bit_cast(unsigned, f); return (u + 0x7fffu + ((u >> 16) & 1u)) >> 16; }
__device__ __forceinline__ unsigned pk2(float lo, float hi) { return f2bf(lo) | (f2bf(hi) << 16); }
__device__ __forceinline__ float bf2f(unsigned short b) { return __builtin_bit_cast(float, (unsigned)b << 16); }
__device__ __forceinline__ float bflo(unsigned w) { return __builtin_bit_cast(float, w << 16); }
__device__ __forceinline__ float bfhi(unsigned w) { return __builtin_bit_cast(float, w & 0xffff0000u); }
typedef __bf16 bf16x2_t __attribute__((ext_vector_type(2)));
__device__ __forceinline__ unsigned cvt_pk_bf16(float lo, float hi) { f32x2 v = {lo, hi}; bf16x2_t b = __builtin_convertvector(v, bf16x2_t); return __builtin_bit_cast(unsigned, b); }
__device__ __forceinline__ float shx(float v, int o, int lane) { return __builtin_bit_cast(float, __builtin_amdgcn_ds_bpermute((lane ^ o) << 2, __builtin_bit_cast(int, v))); }
__device__ __forceinline__ float wave_sum(float v, int lane) {
    (void)lane; int x;
    x = __builtin_amdgcn_update_dpp(0, __builtin_bit_cast(int, v), 0xB1, 0xf, 0xf, true); v += __builtin_bit_cast(float, x);
    x = __builtin_amdgcn_update_dpp(0, __builtin_bit_cast(int, v), 0x4E, 0xf, 0xf, true); v += __builtin_bit_cast(float, x);
    x = __builtin_amdgcn_update_dpp(0, __builtin_bit_cast(int, v), 0x141, 0xf, 0xf, true); v += __builtin_bit_cast(float, x);
    x = __builtin_amdgcn_update_dpp(0, __builtin_bit_cast(int, v), 0x140, 0xf, 0xf, true); v += __builtin_bit_cast(float, x);
    x = __builtin_amdgcn_update_dpp(0, __builtin_bit_cast(int, v), 0x142, 0xa, 0xf, false); v += __builtin_bit_cast(float, x);
    x = __builtin_amdgcn_update_dpp(0, __builtin_bit_cast(int, v), 0x143, 0xc, 0xf, false); v += __builtin_bit_cast(float, x);
    return __builtin_bit_cast(float, __builtin_amdgcn_readlane(__builtin_bit_cast(int, v), 63));
}
__device__ __forceinline__ float sigmoidf_(float x) { return __builtin_amdgcn_rcpf(1.f + __builtin_amdgcn_exp2f(-1.4426950408889634f * x)); }
__device__ __forceinline__ f32x2 gelu_pk(f32x2 v) {
    const f32x2 av = __builtin_elementwise_abs(v), d = av * 0.2316418882f + 1.0f;
    f32x2 t; t.x = __builtin_amdgcn_rcpf(d.x); t.y = __builtin_amdgcn_rcpf(d.y);
    f32x2 q = t * 0.5307027145f + (-0.7265760135f); q = q * t + 0.7107068705f; q = q * t + (-0.142248368f); q = q * t + 0.127414796f; q = q * t;
    const f32x2 s = (v * v) * (-0.72134752044f);
    f32x2 e; e.x = __builtin_amdgcn_exp2f(s.x); e.y = __builtin_amdgcn_exp2f(s.y);
    const f32x2 m = v * (q * e), r = v - m;
    f32x2 o; o.x = v.x < 0.f ? m.x : r.x; o.y = v.y < 0.f ? m.y : r.y; return o;
}
__device__ __forceinline__ f32x4 gelu4(f32x4 v) { f32x2 a = gelu_pk((f32x2){v[0], v[1]}), b = gelu_pk((f32x2){v[2], v[3]}); return (f32x4){a.x, a.y, b.x, b.y}; }
__device__ __forceinline__ f32x4 sigm4(f32x4 v) { return (f32x4){sigmoidf_(v[0]), sigmoidf_(v[1]), sigmoidf_(v[2]), sigmoidf_(v[3])}; }
__device__ __forceinline__ v4u pack8(f32x4 a, f32x4 b) { v4u w; w.x = cvt_pk_bf16(a[0], a[1]); w.y = cvt_pk_bf16(a[2], a[3]); w.z = cvt_pk_bf16(b[0], b[1]); w.w = cvt_pk_bf16(b[2], b[3]); return w; }

__device__ __forceinline__ float sat8(float x) { return __builtin_amdgcn_fmed3f(x, -448.f, 448.f); }
__device__ __forceinline__ unsigned pk4_fp8(float a, float b, float c, float d) { int r = __builtin_amdgcn_cvt_pk_fp8_f32(sat8(a), sat8(b), 0, false); r = __builtin_amdgcn_cvt_pk_fp8_f32(sat8(c), sat8(d), r, true); return (unsigned)r; }
#ifndef MOE2_FP8
#define MOE2_FP8 1
#endif
#ifndef MOE1_FP8
#define MOE1_FP8 1
#endif
constexpr float WGU8_SCALE = MOE1_FP8 ? 32.f : 1.f, WD8_SCALE = MOE2_FP8 ? 16.f : 1.f, HID8_SCALE = MOE2_FP8 ? 8.f : 1.f;
constexpr float YBC8_SCALE = 16.f, WBR8_SCALE = 32.f;
constexpr float MRG8_SCALE = 16.f, WOUT8_SCALE = 32.f;
constexpr float WG8_SCALE = 32.f;
#define XB_TMO      128
#define XB_XCNT(j)  (256  + 64 * (j))
#define XB_XSUB(j)  (1280 + 64 * (j))
#define XB_XGEN(j)  (2304 + 64 * (j))
#define XB_TOP      3328
#define XB_TOPGEN   3392
#define XCD_BAR_WORDS 3456
#define XB_SPIN_CAP (1u << 18)
__device__ __forceinline__ unsigned xb_ld(unsigned* p)              { return __hip_atomic_load(p, __ATOMIC_RELAXED, __HIP_MEMORY_SCOPE_AGENT); }
__device__ __forceinline__ unsigned xb_add(unsigned* p, unsigned v) { return __hip_atomic_fetch_add(p, v, __ATOMIC_RELAXED, __HIP_MEMORY_SCOPE_AGENT); }
__device__ __forceinline__ unsigned xb_xcc_id() { return (unsigned)__builtin_amdgcn_s_getreg((3 << 11) | 20) & 0xFu; }
#define XB_SPIN(cond, bar) do { unsigned _sp = 0; while (cond) { __builtin_amdgcn_s_sleep(1); \
    if ((++_sp & 255u) == 0u) { if (xb_ld(&(bar)[XB_TMO])) break; if (_sp > XB_SPIN_CAP) { atomicAdd(&(bar)[XB_TMO], 1u); break; } } } } while (0)
struct XcdBarrier { unsigned* bar; unsigned x; volatile LAS unsigned* st; };
__device__ __forceinline__ XcdBarrier xcd_barrier_post(unsigned* bar, volatile LAS unsigned* st) {
    XcdBarrier b; b.bar = bar; b.x = xb_xcc_id(); b.st = st;
    if (threadIdx.x == 0) (void)xb_add(&bar[XB_XCNT(b.x)], 1u);
    return b;
}
__device__ __forceinline__ void xcd_barrier_complete(unsigned* bar, unsigned x, unsigned& nloc, unsigned& nx) {
    const unsigned G = gridDim.x * gridDim.y * gridDim.z;
    unsigned sum, cnt, mine, sp = 0u;
    for (;;) {
        sum = 0u; cnt = 0u; mine = 0u;
#pragma unroll 1
        for (unsigned j = 0; j < 16; ++j) { const unsigned c = xb_ld(&bar[XB_XCNT(j)]); sum += c; cnt += (c > 0u) ? 1u : 0u; mine = (j == x) ? c : mine; }
        if (sum == G) break;
        __builtin_amdgcn_s_sleep(1);
        if ((++sp & 255u) == 0u) { if (xb_ld(&bar[XB_TMO])) break; if (sp > XB_SPIN_CAP) { atomicAdd(&bar[XB_TMO], 1u); break; } }
    }
    nloc = mine > 0u ? mine : 1u; nx = cnt > 0u ? cnt : 1u;
}
__device__ __forceinline__ void xcd_barrier(const XcdBarrier& b) {
    asm volatile("s_waitcnt vmcnt(0)" ::: "memory");
    __syncthreads();
    if (threadIdx.x == 0) {
        unsigned* bar = b.bar;
        __builtin_amdgcn_s_waitcnt(0);
        unsigned nloc = b.st[0], nx = b.st[1];
        if (nloc == 0u) { xcd_barrier_complete(bar, b.x, nloc, nx); b.st[0] = nloc; b.st[1] = nx; }
        const unsigned old = xb_add(&bar[XB_XSUB(b.x)], 1u);
        const unsigned gen = old / nloc;
        if (old + 1u == (gen + 1u) * nloc) {
            __builtin_amdgcn_fence(__ATOMIC_RELEASE, "agent");
            asm volatile("s_waitcnt vmcnt(0)" ::: "memory");
            const unsigned og = xb_add(&bar[XB_TOP], 1u);
            const unsigned tg = og / nx;
            if (og + 1u == (tg + 1u) * nx) xb_add(&bar[XB_TOPGEN], 1u);
            else XB_SPIN(xb_ld(&bar[XB_TOPGEN]) == tg, bar);
            __builtin_amdgcn_fence(__ATOMIC_ACQUIRE, "agent");
            xb_add(&bar[XB_XGEN(b.x)], 1u);
            asm volatile("s_waitcnt vmcnt(0)" ::: "memory");
        } else {
            XB_SPIN(xb_ld(&bar[XB_XGEN(b.x)]) == gen, bar);
            __builtin_amdgcn_fence(__ATOMIC_ACQUIRE, "agent");
            asm volatile("s_waitcnt vmcnt(0)" ::: "memory");
        }
    }
    __syncthreads();
}

struct Unit { const GAS char* A; const GAS char* B; const GAS char* A2; const GAS char* B2; int pm, pn, aux, nv; };

constexpr int NXCD = 8, WGM = 8;
__device__ __forceinline__ void tile_order(int L, int nM, int nN, int& pm, int& pn) {
    const int nwg = nM * nN;
    int wgid = L; { const int q = nwg / NXCD, r = nwg % NXCD, xcd = wgid % NXCD, off = wgid / NXCD; wgid = (xcd < r ? xcd * (q + 1) : r * (q + 1) + (xcd - r) * q) + off; }
    const int nig = WGM * nN, gid = wgid / nig, fm = gid * WGM, gsz = (nM - fm) < WGM ? (nM - fm) : WGM;
    pm = fm + ((wgid % nig) % gsz); pn = (wgid % nig) / gsz;
}

struct SchedInProj {
    static constexpr bool GATHER = false;
    const GAS char* H; const GAS char* Win; const GAS char* MemH; const GAS char* Wmkv; int G, c, mode;
    __device__ __forceinline__ bool next(int i, Unit& u) const {
        int L = i * G + c; constexpr int N1 = 64 * 8, N2 = 4 * 8;
        if (mode == 2) L += N1;
        if (L >= (mode == 1 ? N1 : N1 + N2)) return false;
        if (L < N1) { int pm, pn; tile_order(L, 64, 8, pm, pn); u.pm = pm; u.pn = pn; u.aux = 0; u.A = H + (size_t)pm * 256 * D * 2; u.B = Win + (size_t)pn * 256 * D * 2; }
        else { const int r = L - N1; u.pm = r & 3; u.pn = r >> 2; u.aux = 1; u.A = MemH + (size_t)u.pm * 256 * D * 2; u.B = Wmkv + (size_t)u.pn * 256 * D * 2; }
        u.A2 = u.A; u.B2 = u.B; return true;
    }
};
struct SchedGate {
    static constexpr bool GATHER = false;
    const GAS char* H8; const GAS char* Wg8; int G, c, rem, ibeg, iend;
    __device__ __forceinline__ bool next(int i0, Unit& u) const {
        constexpr int NF = 64 * 34; int L; const int i = i0 + ibeg; if (i >= iend) return false;
        const int nh = (NF + 3 * rem + G - 1) / G;
        if (rem == 0 || nh < 3) { L = i * G + c; if (L >= NF) return false; }
        else { const int Gh = G - rem; const int nhT = nh * Gh < NF ? nh * Gh : NF;
            if (c >= rem) { L = i * Gh + (c - rem); if (i >= nh || L >= nhT) return false; }
            else { L = nhT + i * rem + c; if (L >= NF) return false; } }
        int pm, pn; tile_order(L, 64, 34, pm, pn); u.pm = pm; u.pn = pn; u.aux = 0;
        u.A = H8 + (size_t)pm * 256 * D; u.B = Wg8 + (size_t)pn * 256 * D; u.A2 = u.A; u.B2 = u.B; return true;
    }
};
struct SchedMerge {
    static constexpr bool GATHER = false;
    const GAS char* Y; const GAS char* Wbr; int G, c;
    __device__ __forceinline__ bool next(int i, Unit& u) const {
        const int L = i * G + c;
        if (L >= 64 * 8) return false;
        int pm, pn; tile_order(L, 64, 8, pm, pn); u.pm = pm; u.pn = pn; u.aux = 0;
        u.A = Y + (size_t)pm * 256 * 6144; u.B = Wbr + (size_t)pn * 256 * 1024 * 2; u.A2 = u.A; u.B2 = u.B; return true;
    }
};
struct SchedMerge8 {
    static constexpr bool GATHER = false;
    const GAS char* Y; const GAS char* Wbr; int G, c;
    __device__ __forceinline__ bool next(int i, Unit& u) const {
        const int j = i >> 1, n = 1 + (i & 1); const int L = j * G + c;
        if (L >= 64 * 8) return false;
        int pm, pn; tile_order(L, 64, 8, pm, pn); u.pm = pm; u.pn = pn; u.aux = n;
        u.A = Y + (size_t)pm * 256 * 6144 + 1024 + (size_t)n * 1024; u.B = Wbr + (size_t)(n + 1) * 2048 * 1024 + (size_t)pn * 256 * 1024; u.A2 = u.A; u.B2 = u.B; return true;
    }
};
struct SchedOut {
    static constexpr bool GATHER = false;
    const GAS char* Mg; const GAS char* Wout; int G, c, esz;
    __device__ __forceinline__ bool next(int i, Unit& u) const {
        const int L = i * G + c; if (L >= 64 * 8) return false;
        int pm, pn; tile_order(L, 64, 8, pm, pn); u.pm = pm; u.pn = pn; u.aux = 0;
        u.A = Mg + (size_t)pm * 256 * D * esz; u.B = Wout + (size_t)pn * 256 * D * esz; u.A2 = u.A; u.B2 = u.B; return true;
    }
};
__device__ __forceinline__ int bucket_of_tile(const volatile LAS unsigned* lw, int rt) {
    int b = 0;
#pragma unroll 1
    for (int k = 1; k < NBUCKET; ++k) b = ((int)lw[LW_TSTART + k] <= rt) ? k : b;
    return b;
}
__device__ __forceinline__ void bucket_experts(int b, int& elo, int& ehi) { const int g = b / 6, pi = b - 6 * g; elo = 4 * g + ((2368 >> (2 * pi)) & 3); ehi = 4 * g + ((4025 >> (2 * pi)) & 3); }
struct SchedMoe1 {
    static constexpr bool GATHER = true;
    const GAS char* Hb; const GAS char* Wgu; const GAS int* perm; const volatile LAS unsigned* lw; int G, vcu;
    __device__ __forceinline__ bool next(int i, Unit& u) const {
        const int L = i * G + vcu, rt = L >> 3, pn = L & 7; const int ntile = (int)lw[LW_NT];
        if (rt >= ntile) return false;
        const int b = bucket_of_tile(lw, rt); int elo, ehi; bucket_experts(b, elo, ehi);
        const int e = __builtin_amdgcn_readfirstlane(pn < 4 ? elo : ehi); const int lt = rt - (int)lw[LW_TSTART + b];
        u.pm = rt; u.pn = pn; u.aux = __builtin_amdgcn_readfirstlane(b * T + lt * 256); u.nv = __builtin_amdgcn_readfirstlane((int)lw[LW_CNT + b] - lt * 256);
        u.A = Hb; u.B = Wgu + ((size_t)e * 1024 + (size_t)(pn & 3) * 256) * D * (MOE1_FP8 ? 1 : 2); u.A2 = u.A; u.B2 = u.B; return true;
    }
    __device__ __forceinline__ void aoffs(const Unit& u, const int (&R)[2], const int (&Cc)[2], unsigned (&o)[2][2]) const {
#pragma unroll
        for (int h = 0; h < 2; ++h)
#pragma unroll
            for (int i = 0; i < 2; ++i) { const int rr = 128 * h + R[i]; int tok = perm[u.aux + (rr < u.nv ? rr : 0)]; tok = rr < u.nv ? tok : 0; o[h][i] = (unsigned)tok * (unsigned)(D * (MOE1_FP8 ? 1 : 2)) + (unsigned)(Cc[i] * 2); }
    }
};
struct SchedMoe2 {
    static constexpr bool GATHER = false;
    const GAS char* HID; const GAS char* Wd; const volatile LAS unsigned* lw; int G, vcu;
    __device__ __forceinline__ bool next(int i, Unit& u) const {
        const int L = i * G + vcu, rt = L >> 3, pn = L & 7; const int ntile = (int)lw[LW_NT];
        if (rt >= ntile) return false;
        const int b = bucket_of_tile(lw, rt); int elo, ehi; bucket_experts(b, elo, ehi);
        elo = __builtin_amdgcn_readfirstlane(elo); ehi = __builtin_amdgcn_readfirstlane(ehi); const int lt = rt - (int)lw[LW_TSTART + b];
        u.pm = rt; u.pn = pn; u.aux = __builtin_amdgcn_readfirstlane(b * T + lt * 256); u.nv = __builtin_amdgcn_readfirstlane((int)lw[LW_CNT + b] - lt * 256);
        constexpr int ES = MOE2_FP8 ? 1 : 2;
        u.A = HID + (size_t)rt * 256 * 1024 * ES; u.A2 = u.A + 512 * ES;
        u.B = Wd + ((size_t)elo * D + (size_t)pn * 256) * DFF * ES; u.B2 = Wd + ((size_t)ehi * D + (size_t)pn * 256) * DFF * ES; return true;
    }
};

struct EpiInProj {
    static constexpr bool PAIR = false, HASPRE = false, HASROW = false, WIDE8 = false;
    GAS bf16 *P1, *P2, *P3, *P4, *KVM;
    __device__ __forceinline__ void tile8(const Unit& u, int r, int c, f32x4 v0, f32x4 v1) const {
        const size_t row = (size_t)u.pm * 256 + r; const int pn = u.pn;
        if (u.aux) { *(GAS v4u*)(KVM + row * 2048 + pn * 256 + c) = pack8(v0, v1); return; }
        *(GAS v4u*)(P1 + row * 2048 + pn * 256 + c) = pack8(gelu4(v0), gelu4(v1));
    }
};
struct EpiNull { static constexpr bool PAIR = false, HASPRE = false, HASROW = false, WIDE8 = false; GAS float* sink;
    __device__ __forceinline__ void tile8(const Unit& u, int r, int c, f32x4 v0, f32x4 v1) const { if (v0[0] == 1.2345e30f && v1[3] == -7.7e29f) sink[r] = 1.f; } };
struct EpiGate {
    static constexpr bool PAIR = false, HASPRE = false, HASROW = false;
    GAS unsigned char* P4; GAS bf16* P2; GAS bf16* P3;
    __device__ __forceinline__ void tile8(const Unit& u, int r, int c, f32x4 v0, f32x4 v1) const {
        const size_t row = (size_t)u.pm * 256 + r; const float sc = 1.f / WG8_SCALE;
        if (u.pn < 6) { *(GAS v4u*)(P2 + row * 1536 + u.pn * 256 + c) = pack8(v0 * sc, v1 * sc); return; }
        if (u.pn < 10) { *(GAS v4u*)(P3 + row * 1024 + (u.pn - 6) * 256 + c) = pack8(v0 * sc, v1 * sc); return; }
        *(GAS v2u*)(P4 + row * 6144 + (u.pn - 10) * 256 + c) = pack8u(v0, v1);
    }
    static constexpr bool WIDE8 = true;
    __device__ __forceinline__ bool wide(const Unit& u) const { return u.pn >= 10; }
    __device__ __forceinline__ v2u pack8u(f32x4 v0, f32x4 v1) const { const float sc = 1.f / WG8_SCALE;
        const f32x4 a = sigm4(v0 * sc) * 255.f + 0.5f, b = sigm4(v1 * sc) * 255.f + 0.5f;
        v2u o; o.x = (unsigned)a[0] | ((unsigned)a[1] << 8) | ((unsigned)a[2] << 16) | ((unsigned)a[3] << 24); o.y = (unsigned)b[0] | ((unsigned)b[1] << 8) | ((unsigned)b[2] << 16) | ((unsigned)b[3] << 24); return o; }
    __device__ __forceinline__ void store16(const Unit& u, int r, int c, v4u o) const { *(GAS v4u*)(P4 + ((size_t)u.pm * 256 + r) * 6144 + (u.pn - 10) * 256 + c) = o; }
};
struct EpiMerge {
    static constexpr bool PAIR = false, HASPRE = true, HASROW = false;
    const GAS unsigned char* P4; GAS bf16* MP; GAS bf16* MG; float sc; int out8;
    struct Pre { v2u g; v4u p; };
    __device__ __forceinline__ void pre(const Unit& u, int r, int c, Pre& q) const {
        const size_t row = (size_t)u.pm * 256 + r; const int col = u.pn * 256 + c;
        q.g = *(const GAS v2u*)(P4 + row * 6144 + u.aux * 2048 + col);
        if (u.aux > 0) q.p = *(const GAS v4u*)(MP + row * D + col); else { unsigned zz = 0u; asm volatile("" : "+v"(zz)); q.p = (v4u){zz, zz, zz, zz}; }
    }
    __device__ __forceinline__ void post(const Unit& u, int r, int c, f32x4 v0, f32x4 v1, const Pre& q) const {
        const size_t row = (size_t)u.pm * 256 + r; const int col = u.pn * 256 + c;
        f32x4 a = (f32x4){(float)(q.g.x & 255u), (float)((q.g.x >> 8) & 255u), (float)((q.g.x >> 16) & 255u), (float)(q.g.x >> 24)} * (v0 * sc) + (f32x4){bflo(q.p.x), bfhi(q.p.x), bflo(q.p.y), bfhi(q.p.y)};
        f32x4 b = (f32x4){(float)(q.g.y & 255u), (float)((q.g.y >> 8) & 255u), (float)((q.g.y >> 16) & 255u), (float)(q.g.y >> 24)} * (v1 * sc) + (f32x4){bflo(q.p.z), bfhi(q.p.z), bflo(q.p.w), bfhi(q.p.w)};
        if (u.aux < 2) *(GAS v4u*)(MP + row * D + col) = pack8(a, b);
        else if (out8) { a = a * MRG8_SCALE; b = b * MRG8_SCALE; *(GAS v2u*)((GAS unsigned char*)MG + (WS_H8 - WS_H) + row * D + col) = (v2u){pk4_fp8(a[0], a[1], a[2], a[3]), pk4_fp8(b[0], b[1], b[2], b[3])}; }
        else *(GAS v4u*)(MG + row * D + col) = pack8(a, b);
    }
    __device__ __forceinline__ void tile8(const Unit& u, int r, int c, f32x4 v0, f32x4 v1) const { Pre q; pre(u, r, c, q); post(u, r, c, v0, v1, q); }
};
struct EpiOut {
    static constexpr bool PAIR = false, HASPRE = true, HASROW = false;
    const GAS float* xin; GAS bf16* xb; int in32; float sc;
    struct Pre { f32x4 a, b; };
    __device__ __forceinline__ void pre(const Unit& u, int r, int c, Pre& q) const {
        const size_t off = ((size_t)u.pm * 256 + r) * D + u.pn * 256 + c;
        if (in32) { q.a = *(const GAS f32x4*)(xin + off); q.b = *(const GAS f32x4*)(xin + off + 4); }
        else { const v4u t = *(const GAS v4u*)(xb + off); q.a = (f32x4){bflo(t.x), bfhi(t.x), bflo(t.y), bfhi(t.y)}; q.b = (f32x4){bflo(t.z), bfhi(t.z), bflo(t.w), bfhi(t.w)}; }
    }
    __device__ __forceinline__ void post(const Unit& u, int r, int c, f32x4 v0, f32x4 v1, const Pre& q) const {
        const size_t off = ((size_t)u.pm * 256 + r) * D + u.pn * 256 + c; *(GAS v4u*)(xb + off) = pack8(q.a + v0 * sc, q.b + v1 * sc);
    }
    __device__ __forceinline__ void tile8(const Unit& u, int r, int c, f32x4 v0, f32x4 v1) const { Pre q; pre(u, r, c, q); post(u, r, c, v0, v1, q); }
};
struct EpiMoe1 {
    static constexpr bool PAIR = true, HASPRE = false, HASROW = true;
    const GAS float* roww; GAS bf16* HID;
    typedef f32x2 RowT;
    __device__ __forceinline__ f32x2 rowload(const Unit& u, int r) const { const bool ok = r < u.nv; const GAS float* p = roww + (size_t)(u.aux + (ok ? r : 0)) * 4; const f32x2 v = (f32x2){p[u.pn >> 2], p[2]}; return ok ? v : (f32x2){0.f, 0.f}; }
    __device__ __forceinline__ void pair8w(const Unit& u, int r, int c, f32x4 g0, f32x4 g1, f32x4 u0, f32x4 u1, f32x2 wr2) const {
        const size_t row = (size_t)u.pm * 256 + r; const int seg = u.pn >> 2; const float rstd = wr2[1] * (1.f / WGU8_SCALE), w = wr2[0] * rstd * HID8_SCALE;
        f32x4 a, b;
#pragma unroll
        for (int k = 0; k < 4; ++k) { const float ga = g0[k] * rstd, gb = g1[k] * rstd; a[k] = ga * sigmoidf_(ga) * u0[k] * w; b[k] = gb * sigmoidf_(gb) * u1[k] * w; }
        if (MOE2_FP8) *(GAS v2u*)((GAS unsigned char*)HID + row * 1024 + seg * 512 + (u.pn & 3) * 128 + c) = (v2u){pk4_fp8(a[0], a[1], a[2], a[3]), pk4_fp8(b[0], b[1], b[2], b[3])};
        else *(GAS v4u*)(HID + row * 1024 + seg * 512 + (u.pn & 3) * 128 + c) = pack8(a, b);
    }
    __device__ __forceinline__ void pair8(const Unit& u, int r, int c, f32x4 g0, f32x4 g1, f32x4 u0, f32x4 u1) const { pair8w(u, r, c, g0, g1, u0, u1, rowload(u, r)); }
};
struct EpiMoe2 {
    static constexpr bool PAIR = false, HASPRE = true, HASROW = true;
    const GAS int* perm; GAS bf16* xb; GAS float* xout; int last;
    typedef int RowT;
    struct Pre { v4u p; };
    __device__ __forceinline__ int rowload(const Unit& u, int r) const { const bool ok = r < u.nv; const int tok = perm[u.aux + (ok ? r : 0)]; return ok ? tok : -1; }
    __device__ __forceinline__ void pre(const Unit& u, int r, int c, Pre& q, int tok) const {
        q.p = *(const GAS v4u*)(xb + (size_t)(tok < 0 ? 0 : tok) * D + u.pn * 256 + c);
    }
    __device__ __forceinline__ void post(const Unit& u, int r, int c, f32x4 v0, f32x4 v1, const Pre& q, int tok) const {
        if (tok < 0) return;
        const float sc = 1.f / (HID8_SCALE * WD8_SCALE); const size_t off = (size_t)tok * D + u.pn * 256 + c;
        const f32x4 a = (f32x4){bflo(q.p.x), bfhi(q.p.x), bflo(q.p.y), bfhi(q.p.y)} + v0 * sc, b = (f32x4){bflo(q.p.z), bfhi(q.p.z), bflo(q.p.w), bfhi(q.p.w)} + v1 * sc;
        if (last) { *(GAS f32x4*)(xout + off) = a; *(GAS f32x4*)(xout + off + 4) = b; }
        else *(GAS v4u*)(xb + off) = pack8(a, b);
    }
    __device__ __forceinline__ void tile8(const Unit& u, int r, int c, f32x4 v0, f32x4 v1) const { Pre q; const int tok = rowload(u, r); pre(u, r, c, q, tok); post(u, r, c, v0, v1, q, tok); }
};

template <class Epi, class Sched, int NSEG>
__device__ __forceinline__ void gemm_simple(int lda, int ldb, int nt, const Sched& S, const Epi& E) {
    const int tid = threadIdx.x, wid = tid >> 6, lane = tid & 63, fr = lane & 15, fq = lane >> 4;
    Unit u;
    for (int i = 0; S.next(i, u); ++i) {
        constexpr int NCG = Epi::PAIR ? 4 : 8;
        for (int sub = wid; sub < 16 * NCG; sub += NWAVES) {
            const int rt = sub / NCG, cg = sub % NCG;
            f32x4 acc[4];
#pragma unroll
            for (int k = 0; k < 4; ++k) acc[k] = (f32x4){0.f, 0.f, 0.f, 0.f};
            for (int seg = 0; seg < NSEG; ++seg) {
                size_t arow = (size_t)(rt * 16 + fr) * lda;
                if constexpr (Sched::GATHER) { const int R1[2] = {(rt * 16 + fr) & 127, 0}; const int C1[2] = {0, 0}; unsigned o[2][2]; S.aoffs(u, R1, C1, o); arow = o[(rt * 16 + fr) >> 7][0]; }
                const GAS char* Ab = (seg ? u.A2 : u.A) + arow + fq * 16;
                const GAS char* Bb = (seg ? u.B2 : u.B) + fq * 16;
                const int brow0 = cg * 32 + 8 * (fr >> 2) + (fr & 3);
                for (int ks = 0; ks < nt * 2; ++ks) {
                    const bf16x8 a = *(const GAS bf16x8*)(Ab + ks * 64);
#pragma unroll
                    for (int n = 0; n < 2; ++n) {
                        const bf16x8 w = *(const GAS bf16x8*)(Bb + (size_t)(brow0 + 4 * n) * ldb + ks * 64);
                        acc[n] = __builtin_amdgcn_mfma_f32_16x16x32_bf16(w, a, acc[n], 0, 0, 0);
                        if (Epi::PAIR) { const bf16x8 w2 = *(const GAS bf16x8*)(Bb + (size_t)(128 + brow0 + 4 * n) * ldb + ks * 64);
                            acc[2 + n] = __builtin_amdgcn_mfma_f32_16x16x32_bf16(w2, a, acc[2 + n], 0, 0, 0); }
                    }
                }
            }
            if constexpr (Epi::PAIR) E.pair8(u, rt * 16 + fr, cg * 32 + 8 * fq, acc[0], acc[1], acc[2], acc[3]);
            else E.tile8(u, rt * 16 + fr, cg * 32 + 8 * fq, acc[0], acc[1]);
        }
    }
}

#ifndef PG8_ALIGN_EPI
#define PG8_ALIGN_EPI 1
#endif
namespace pg8 {
constexpr int BM = 256, BK = 64, HALF = 128, HTB = HALF * BK * 2, STAGE_BYTES = 8 * HTB;
__device__ __forceinline__ int lds_byte(int r, int c) { const int st = (r >> 4) * 2 + (c >> 5), rr = r & 15, cc = c & 31, ob = rr * 64 + cc * 2; return st * 1024 + (ob ^ (((ob >> 9) & 1) << 5)); }
__device__ __forceinline__ void stage_rc(int b, int& R, int& C) { const int st = b / 1024, sb = b % 1024, swz = sb ^ (((sb >> 9) & 1) << 5); R = (st >> 1) * 16 + swz / 64; C = (st & 1) * 32 + (swz % 64) / 2; }
__device__ __forceinline__ int perm32(int rho) { const int n = rho >> 4, i = rho & 15; return 8 * (i >> 2) + 4 * n + (i & 3); }

__device__ __forceinline__ void glds_saddr(const GAS char* gbase, unsigned voff, unsigned lds_dst) {
    unsigned keep;
    asm volatile("s_mov_b32 %0, m0\n\ts_mov_b32 m0, %3\n\ts_nop 0\n\tglobal_load_lds_dwordx4 %1, %2\n\ts_mov_b32 m0, %0" : "=&s"(keep) : "v"(voff), "s"(gbase), "s"(lds_dst) : "memory");
}
template <class Epi> __device__ __forceinline__ void run_epi(const Epi& E, const f32x4 (&acc)[2][2][4][2], const Unit& u, int wr, int wc, int fr, int fq) {
    if constexpr (Epi::PAIR && Epi::HASROW) {
        typename Epi::RowT rv[2][4];
#pragma unroll
        for (int ai = 0; ai < 2; ++ai)
#pragma unroll
            for (int m = 0; m < 4; ++m) rv[ai][m] = E.rowload(u, ai * HALF + wr * 64 + m * 16 + fr);
#pragma unroll
        for (int ai = 0; ai < 2; ++ai)
#pragma unroll
            for (int m = 0; m < 4; ++m) {
                int r = ai * HALF + wr * 64 + m * 16 + fr; asm volatile("" : "+v"(r) :: "memory");
                E.pair8w(u, r, wc * 32 + 8 * fq, acc[ai][0][m][0], acc[ai][0][m][1], acc[ai][1][m][0], acc[ai][1][m][1], rv[ai][m]);
                asm volatile("" ::: "memory");
            }
    } else if constexpr (Epi::HASPRE) {
        typename std::conditional<Epi::HASROW, int, char>::type rv[2][4];
        if constexpr (Epi::HASROW) {
#pragma unroll
            for (int ai = 0; ai < 2; ++ai)
#pragma unroll
                for (int m = 0; m < 4; ++m) rv[ai][m] = E.rowload(u, ai * HALF + wr * 64 + m * 16 + fr);
        }
#pragma unroll
        for (int ai = 0; ai < 2; ++ai)
#pragma unroll
            for (int mp = 0; mp < 2; ++mp) {
                int r0 = ai * HALF + wr * 64 + (2 * mp) * 16 + fr; asm volatile("" : "+v"(r0) :: "memory");
                const int c0 = wc * 32 + 8 * fq;
                typename Epi::Pre q[2][2];
                if constexpr (Epi::HASROW) {
#pragma unroll
                    for (int mm = 0; mm < 2; ++mm)
#pragma unroll
                        for (int bj = 0; bj < 2; ++bj) E.pre(u, r0 + 16 * mm, bj * HALF + c0, q[mm][bj], rv[ai][2 * mp + mm]);
#pragma unroll
                    for (int mm = 0; mm < 2; ++mm)
#pragma unroll
                        for (int bj = 0; bj < 2; ++bj) E.post(u, r0 + 16 * mm, bj * HALF + c0, acc[ai][bj][2 * mp + mm][0], acc[ai][bj][2 * mp + mm][1], q[mm][bj], rv[ai][2 * mp + mm]);
                } else {
#pragma unroll
                for (int mm = 0; mm < 2; ++mm)
#pragma unroll
                    for (int bj = 0; bj < 2; ++bj) E.pre(u, r0 + 16 * mm, bj * HALF + c0, q[mm][bj]);
#pragma unroll
                for (int mm = 0; mm < 2; ++mm)
#pragma unroll
                    for (int bj = 0; bj < 2; ++bj) E.post(u, r0 + 16 * mm, bj * HALF + c0, acc[ai][bj][2 * mp + mm][0], acc[ai][bj][2 * mp + mm][1], q[mm][bj]);
                }
                asm volatile("" ::: "memory");
            }
    } else {
    if constexpr (!Epi::PAIR && Epi::WIDE8) {
        if (E.wide(u)) {
#pragma unroll
            for (int ai = 0; ai < 2; ++ai)
#pragma unroll
                for (int mp = 0; mp < 2; ++mp) {
                    int r0 = ai * HALF + wr * 64 + (2 * mp) * 16 + fr; asm volatile("" : "+v"(r0) :: "memory");
#pragma unroll
                    for (int bj = 0; bj < 2; ++bj) {
                        v2u a = E.pack8u(acc[ai][bj][2 * mp][0], acc[ai][bj][2 * mp][1]), b = E.pack8u(acc[ai][bj][2 * mp + 1][0], acc[ai][bj][2 * mp + 1][1]);
                        asm volatile("s_nop 1\n\tv_permlane16_swap_b32 %0, %1" : "+v"(a.x), "+v"(b.x));
                        asm volatile("s_nop 1\n\tv_permlane16_swap_b32 %0, %1" : "+v"(a.y), "+v"(b.y));
                        const int odd = fq & 1;
                        E.store16(u, r0 + 16 * odd, bj * HALF + wc * 32 + 8 * (fq - odd), (v4u){a.x, a.y, b.x, b.y});
                    }
                    asm volatile("" ::: "memory");
                }
            return;
        }
    }
#pragma unroll
    for (int ai = 0; ai < 2; ++ai)
#pragma unroll
        for (int m = 0; m < 4; ++m) {
            int r = ai * HALF + wr * 64 + m * 16 + fr; asm volatile("" : "+v"(r) :: "memory");
            if constexpr (Epi::PAIR) E.pair8(u, r, wc * 32 + 8 * fq, acc[ai][0][m][0], acc[ai][0][m][1], acc[ai][1][m][0], acc[ai][1][m][1]);
            else {
#pragma unroll
                for (int bj = 0; bj < 2; ++bj) { E.tile8(u, r, bj * HALF + wc * 32 + 8 * fq, acc[ai][bj][m][0], acc[ai][bj][m][1]); asm volatile("" ::: "memory"); }
            }
            asm volatile("" ::: "memory");
        }
    }
}

#define PG8_KPTR(base, base2, tau) ((NSEG == 2 && (tau) >= nt) ? (base2) + (size_t)((tau) - nt) * kstep : (base) + (size_t)(tau) * kstep)
typedef int v8i __attribute__((ext_vector_type(8)));
template <class Epi, class Sched, int NSEG, bool FP8 = false>
__device__ __forceinline__ void gemm_fast(LAS unsigned char* lds, const int lda, const int ldb, const int nt, const Sched& S, const Epi& E) {
    int tid = threadIdx.x; asm volatile("" : "+v"(tid));
    const int wid = __builtin_amdgcn_readfirstlane(tid >> 6), lane = tid & 63, wr = wid >> 2, wc = wid & 3, fr = lane & 15, fq = lane >> 4;
    const int NT = NSEG * nt;
    unsigned voffB[2]; int RA[2], CA[2];
#pragma unroll
    for (int i = 0; i < 2; ++i) { int R, C; stage_rc(tid * 16 + i * 8192, R, C); const int Rb = (R & ~31) + perm32(R & 31);
        RA[i] = R; CA[i] = C; voffB[i] = (unsigned)(Rb * ldb + C * 2); }
    unsigned vA[2][2], vAn[2][2];
#pragma unroll
    for (int h = 0; h < 2; ++h)
#pragma unroll
        for (int i = 0; i < 2; ++i) { vA[h][i] = (unsigned)((h * HALF + RA[i]) * lda + CA[i] * 2); vAn[h][i] = vA[h][i]; }
    const size_t kstep = (size_t)(BK * 2);
    const size_t hstepB = (size_t)HALF * ldb;
    const unsigned ldsw = (unsigned)wid * 1024u;
    const unsigned lds0 = (unsigned)(size_t)lds;
    const int aoff = lds_byte(wr * 64 + fr, fq * 8), boff = lds_byte(wc * 32 + fr, fq * 8);
    const int aoff8a = aoff, boff8a = boff;
#define PG8_SA(b, h) (((b) * 2 + (h)) * HTB)
#define PG8_SB(b, h) ((4 + (b) * 2 + (h)) * HTB)
#define PG8_STAGE(bufoff, gbase, voff) do { _Pragma("unroll") for (int _i = 0; _i < 2; ++_i) \
        glds_saddr((const GAS char*)(gbase), (voff)[_i], lds0 + (unsigned)((bufoff) + _i * 8192) + ldsw); } while (0)
#define PG8_LDA(dst, b, h) do { _Pragma("unroll") for (int m = 0; m < 4; ++m) _Pragma("unroll") for (int k = 0; k < 2; ++k) dst[m][k] = *(const LAS bf16x8*)(lds + PG8_SA(b, h) + aoff + m * 2048 + k * 1024); } while (0)
#define PG8_LDB(dst, b, h) do { _Pragma("unroll") for (int n = 0; n < 2; ++n) _Pragma("unroll") for (int k = 0; k < 2; ++k) dst[n][k] = *(const LAS bf16x8*)(lds + PG8_SB(b, h) + boff + n * 2048 + k * 1024); } while (0)
#define PG8_MMA(ai, bj, At, Bt) do { __builtin_amdgcn_s_setprio(1); _Pragma("unroll") for (int m = 0; m < 4; ++m) _Pragma("unroll") for (int n = 0; n < 2; ++n) _Pragma("unroll") for (int k = 0; k < 2; ++k) \
        acc[ai][bj][m][n] = __builtin_amdgcn_mfma_f32_16x16x32_bf16(Bt[n][k], At[m][k], acc[ai][bj][m][n], 0, 0, 0); __builtin_amdgcn_s_setprio(0); } while (0)
#define PG8_LD8(dst, off) do { const v4u lo_ = *(const LAS v4u*)(lds + (off)); (dst)[0] = (int)lo_.x; (dst)[1] = (int)lo_.y; (dst)[2] = (int)lo_.z; (dst)[3] = (int)lo_.w; } while (0)
#define PG8_LD8H(dst, off) do { const v4u hi_ = *(const LAS v4u*)(lds + (off)); (dst)[4] = (int)hi_.x; (dst)[5] = (int)hi_.y; (dst)[6] = (int)hi_.z; (dst)[7] = (int)hi_.w; } while (0)
#define PG8_LDA8(dst, b, h) do { _Pragma("unroll") for (int m = 0; m < 4; ++m) { PG8_LD8(dst[m], PG8_SA(b, h) + aoff8a + m * 2048); PG8_LD8H(dst[m], PG8_SA(b, h) + aoff8a + 1024 + m * 2048); } } while (0)
#define PG8_LDB8(dst, b, h) do { _Pragma("unroll") for (int n = 0; n < 2; ++n) { PG8_LD8(dst[n], PG8_SB(b, h) + boff8a + n * 2048); PG8_LD8H(dst[n], PG8_SB(b, h) + boff8a + 1024 + n * 2048); } } while (0)
#define PG8_MMA8(ai, bj, A8_, B8_) do { __builtin_amdgcn_s_setprio(1); _Pragma("unroll") for (int m = 0; m < 4; ++m) _Pragma("unroll") for (int n = 0; n < 2; ++n) \
        asm volatile("v_mfma_scale_f32_16x16x128_f8f6f4 %0, %1, %2, %0, %3, %3 op_sel_hi:[0,0,0]" : "+v"(acc[ai][bj][m][n]) : "v"(B8_[n]), "v"(A8_[m]), "v"(sc127)); __builtin_amdgcn_s_setprio(0); } while (0)
#ifdef DRAIN_ALL
#define PG8_WAIT_V(n) asm volatile("s_waitcnt vmcnt(0)" ::: "memory")
#else
#define PG8_WAIT_V(n) asm volatile("s_waitcnt vmcnt(" #n ")" ::: "memory")
#endif
#define PG8_WAIT_L(n) asm volatile("s_waitcnt lgkmcnt(" #n ")" ::: "memory")
#define PG8_BAR __builtin_amdgcn_s_barrier()
#define PG8_SCHED __builtin_amdgcn_sched_barrier(0)
    Unit cur, nxt; int ui = 0;
    if (!S.next(0, cur)) return;
    if constexpr (Sched::GATHER) S.aoffs(cur, RA, CA, vA);
    f32x4 acc[2][2][4][2];
#pragma unroll
    for (int a = 0; a < 2; ++a)
#pragma unroll
        for (int b = 0; b < 2; ++b)
#pragma unroll
            for (int m = 0; m < 4; ++m)
#pragma unroll
                for (int n = 0; n < 2; ++n) acc[a][b][m][n] = (f32x4){0.f, 0.f, 0.f, 0.f};
    if constexpr (FP8) {
#pragma unroll
        for (int a = 0; a < 2; ++a)
#pragma unroll
            for (int b = 0; b < 2; ++b)
#pragma unroll
                for (int m = 0; m < 4; ++m)
#pragma unroll
                    for (int n = 0; n < 2; ++n) asm volatile("" : "+v"(acc[a][b][m][n]));
        asm volatile("s_nop 7\n\ts_nop 7" ::: "memory");
    }
    int sc127 = 127; asm volatile("" : "+v"(sc127));
    bf16x8 At[4][2], B0[2][2], B1[2][2]; v8i A8[4], B80[2], B81[2];
    {
        const GAS char* cA = cur.A; const GAS char* cB = cur.B;
        PG8_STAGE(PG8_SB(0, 0), cB, voffB); PG8_STAGE(PG8_SB(0, 1), cB + hstepB, voffB); PG8_STAGE(PG8_SA(0, 0), cA, vA[0]); PG8_STAGE(PG8_SA(0, 1), cA, vA[1]);
        if (wr == 1) PG8_BAR;
        PG8_WAIT_V(2); PG8_BAR;
        PG8_STAGE(PG8_SB(1, 0), cB + kstep, voffB); PG8_STAGE(PG8_SA(1, 0), cA + kstep, vA[0]); PG8_STAGE(PG8_SB(1, 1), cB + hstepB + kstep, voffB);
        PG8_WAIT_V(6); PG8_BAR;
    }
    for (;;) {
        const bool has_next = S.next(ui + 1, nxt);
        if (!has_next) nxt = cur;
        if constexpr (Sched::GATHER) { if (has_next) S.aoffs(nxt, RA, CA, vAn); else {
#pragma unroll
            for (int h = 0; h < 2; ++h)
#pragma unroll
                for (int i = 0; i < 2; ++i) vAn[h][i] = vA[h][i]; } }
        for (int t = 0; t < NT; t += 2) {
            const bool last = (t == NT - 2);
            const GAS char* a1 = PG8_KPTR(cur.A, cur.A2, t + 1);
            const GAS char* a2 = last ? nxt.A : PG8_KPTR(cur.A, cur.A2, t + 2); const GAS char* b2 = last ? nxt.B : PG8_KPTR(cur.B, cur.B2, t + 2);
            const GAS char* a3 = a2 + kstep; const GAS char* b3 = b2 + kstep;
            unsigned sa0[2], sa1[2];
#pragma unroll
            for (int i = 0; i < 2; ++i) { if constexpr (Sched::GATHER) { sa0[i] = last ? vAn[0][i] : vA[0][i]; sa1[i] = last ? vAn[1][i] : vA[1][i]; } else { sa0[i] = vA[0][i]; sa1[i] = vA[1][i]; } }
            if constexpr (FP8) { PG8_LDB8(B80, 0, 0); PG8_LDB8(B81, 0, 1); PG8_SCHED; PG8_LDA8(A8, 0, 0); } else { PG8_LDB(B0, 0, 0); PG8_LDB(B1, 0, 1); PG8_SCHED; PG8_LDA(At, 0, 0); } PG8_STAGE(PG8_SA(1, 1), a1, vA[1]);
            PG8_WAIT_V(8); PG8_WAIT_L(0); PG8_BAR; if constexpr (FP8) { PG8_MMA8(0, 0, A8, B80); PG8_MMA8(0, 1, A8, B81); } else { PG8_MMA(0, 0, At, B0); PG8_MMA(0, 1, At, B1); } PG8_BAR; PG8_SCHED;
            if constexpr (FP8) { PG8_LDA8(A8, 0, 1); } else { PG8_LDA(At, 0, 1); } PG8_STAGE(PG8_SB(0, 0), b2, voffB); PG8_STAGE(PG8_SB(0, 1), b2 + hstepB, voffB); PG8_STAGE(PG8_SA(0, 0), a2, sa0);
            PG8_WAIT_V(8); PG8_WAIT_L(0); PG8_BAR; if constexpr (FP8) { PG8_MMA8(1, 0, A8, B80); PG8_MMA8(1, 1, A8, B81); } else { PG8_MMA(1, 0, At, B0); PG8_MMA(1, 1, At, B1); } PG8_BAR; PG8_SCHED;
            if constexpr (FP8) { PG8_LDB8(B80, 1, 0); PG8_LDB8(B81, 1, 1); PG8_SCHED; PG8_LDA8(A8, 1, 0); } else { PG8_LDB(B0, 1, 0); PG8_LDB(B1, 1, 1); PG8_SCHED; PG8_LDA(At, 1, 0); } PG8_STAGE(PG8_SA(0, 1), a2, sa1);
            PG8_WAIT_V(8); PG8_WAIT_L(0); PG8_BAR; if constexpr (FP8) { PG8_MMA8(0, 0, A8, B80); PG8_MMA8(0, 1, A8, B81); } else { PG8_MMA(0, 0, At, B0); PG8_MMA(0, 1, At, B1); } PG8_BAR; PG8_SCHED;
            if constexpr (FP8) { PG8_LDA8(A8, 1, 1); } else { PG8_LDA(At, 1, 1); } PG8_STAGE(PG8_SB(1, 0), b3, voffB); PG8_STAGE(PG8_SB(1, 1), b3 + hstepB, voffB); PG8_STAGE(PG8_SA(1, 0), a3, sa0);
            PG8_WAIT_V(8); PG8_WAIT_L(0); PG8_BAR; if constexpr (FP8) { PG8_MMA8(1, 0, A8, B80); PG8_MMA8(1, 1, A8, B81); } else { PG8_MMA(1, 0, At, B0); PG8_MMA(1, 1, At, B1); } PG8_BAR; PG8_SCHED;
        }
        if (PG8_ALIGN_EPI) { if (wr == 0) PG8_BAR; }
        if constexpr (FP8) asm volatile("s_nop 7\n\ts_nop 7\n\ts_nop 7\n\ts_nop 7" ::: "memory");
        { int t2 = threadIdx.x; asm volatile("" : "+v"(t2)); const int l2 = t2 & 63; run_epi(E, acc, cur, wr, wc, l2 & 15, l2 >> 4); }
        if (!has_next) break;
#pragma unroll
        for (int a = 0; a < 2; ++a)
#pragma unroll
            for (int b = 0; b < 2; ++b)
#pragma unroll
                for (int m = 0; m < 4; ++m)
#pragma unroll
                    for (int n = 0; n < 2; ++n) acc[a][b][m][n] = (f32x4){0.f, 0.f, 0.f, 0.f};
        if constexpr (FP8) {
#pragma unroll
            for (int a = 0; a < 2; ++a)
#pragma unroll
                for (int b = 0; b < 2; ++b)
#pragma unroll
                    for (int m = 0; m < 4; ++m)
#pragma unroll
                        for (int n = 0; n < 2; ++n) asm volatile("" : "+v"(acc[a][b][m][n]));
            asm volatile("s_nop 7\n\ts_nop 7" ::: "memory");
        }
        cur = nxt; ++ui;
        if constexpr (Sched::GATHER) {
#pragma unroll
            for (int h = 0; h < 2; ++h)
#pragma unroll
                for (int i = 0; i < 2; ++i) vA[h][i] = vAn[h][i]; }
        if (PG8_ALIGN_EPI) { if (wr == 1) PG8_BAR; }
    }
    PG8_WAIT_V(0);
    if (!PG8_ALIGN_EPI) { if (wr == 0) PG8_BAR; }
    PG8_BAR;
#undef PG8_SA
#undef PG8_SB
#undef PG8_STAGE
#undef PG8_LDA
#undef PG8_LDA8
#undef PG8_LDB8
#undef PG8_LD8
#undef PG8_LD8H
#undef PG8_MMA8
#undef PG8_LDB
#undef PG8_MMA
#undef PG8_WAIT_V
#undef PG8_WAIT_L
#undef PG8_BAR
#undef PG8_SCHED
}
}

#ifndef REPEAT_MASK
#define REPEAT_MASK 0
#endif
#define NREP(k) (((REPEAT_MASK >> (k)) & 1) ? 2 : 1)
#ifndef FASTMASK
#define FASTMASK 0x19A
#endif
template <int PH, class Epi, class Sched, int NSEG>
__device__ __forceinline__ void gemm_run(LAS unsigned char* lds, int lda, int ldb, int nt, const Sched& S, const Epi& E) {
    if constexpr ((FASTMASK >> PH) & 1) pg8::gemm_fast<Epi, Sched, NSEG>(lds, lda, ldb, nt, S, E);
    else gemm_simple<Epi, Sched, NSEG>(lda, ldb, nt, S, E);
}

struct Args { const float* in[24]; float* out; unsigned char* ws; int ph_lo, ph_hi; };
struct Ctx {
    LAS unsigned char* lds; volatile LAS unsigned* lw;
    GAS float* out; GAS unsigned char* ws; gu32* ctl;
    int tid, lane, wave, vcu, G, bid; float zf;
};

__device__ __forceinline__ void relaunder(Ctx& C) {
    int t = threadIdx.x; asm volatile("" : "+v"(t)); C.tid = t; C.lane = t & 63; C.wave = __builtin_amdgcn_readfirstlane(t >> 6);
    float z = 0.f; asm volatile("" : "+v"(z)); C.zf = z;
    asm volatile("" : "+s"(C.out), "+s"(C.ws), "+s"(C.ctl), "+s"(C.vcu), "+s"(C.G), "+s"(C.bid));
}
__device__ __forceinline__ void rms_row_to_bf16(const GAS float* xrow, const GAS float* gain, GAS bf16* orow, int lane, GAS unsigned char* orow8 = nullptr) {
    const GAS f32x4* xr = (const GAS f32x4*)xrow + lane; const GAS f32x4* gr = (const GAS f32x4*)gain + lane;
    f32x4 v[8]; float s = 0.f;
#pragma unroll
    for (int j = 0; j < 8; ++j) { v[j] = xr[64 * j]; s += (v[j].x * v[j].x + v[j].y * v[j].y) + (v[j].z * v[j].z + v[j].w * v[j].w); }
    const float rstd = 1.f / sqrtf(wave_sum(s, lane) * (1.f / D) + EPS);
    GAS unsigned long long* o8 = (GAS unsigned long long*)orow + lane;
#pragma unroll
    for (int j = 0; j < 8; ++j) { const f32x4 g = gr[64 * j];
        o8[64 * j] = (unsigned long long)pk2(v[j].x * rstd * g.x, v[j].y * rstd * g.y) | ((unsigned long long)pk2(v[j].z * rstd * g.z, v[j].w * rstd * g.w) << 32);
        if (orow8) ((GAS unsigned*)orow8)[64 * j + lane] = pk4_fp8(v[j].x * rstd * g.x, v[j].y * rstd * g.y, v[j].z * rstd * g.z, v[j].w * rstd * g.w); }
}
__device__ __forceinline__ void rms_row_from_bf16(const GAS bf16* xrow, const GAS float* gain, GAS bf16* orow, int lane, GAS unsigned char* orow8) {
    const GAS v4u* xr = (const GAS v4u*)xrow + lane; const GAS f32x4* gr = (const GAS f32x4*)gain + 2 * lane;
    v4u v[4]; float s = 0.f;
#pragma unroll
    for (int j = 0; j < 4; ++j) { v[j] = xr[64 * j]; const float a0 = bflo(v[j].x), a1 = bfhi(v[j].x), a2 = bflo(v[j].y), a3 = bfhi(v[j].y), a4 = bflo(v[j].z), a5 = bfhi(v[j].z), a6 = bflo(v[j].w), a7 = bfhi(v[j].w);
        s += ((a0 * a0 + a1 * a1) + (a2 * a2 + a3 * a3)) + ((a4 * a4 + a5 * a5) + (a6 * a6 + a7 * a7)); }
    const float rstd = 1.f / sqrtf(wave_sum(s, lane) * (1.f / D) + EPS);
#pragma unroll
    for (int j = 0; j < 4; ++j) { const f32x4 g0 = gr[128 * j] * rstd, g1 = gr[128 * j + 1] * rstd;
        const f32x4 a = (f32x4){bflo(v[j].x), bfhi(v[j].x), bflo(v[j].y), bfhi(v[j].y)} * g0, b = (f32x4){bflo(v[j].z), bfhi(v[j].z), bflo(v[j].w), bfhi(v[j].w)} * g1;
        ((GAS v4u*)orow)[64 * j + lane] = pack8(a, b);
        ((GAS v2u*)orow8)[64 * j + lane] = (v2u){pk4_fp8(a[0], a[1], a[2], a[3]), pk4_fp8(b[0], b[1], b[2], b[3])}; }
}
#ifndef LATE_PCT
#define LATE_PCT 2
#endif
struct WTile { const GAS float* W; GAS unsigned char* dst; int K, N, kind, rowmode, nsub, k0, n0; float sc; };
__device__ __forceinline__ void conv_tile_load(const WTile& t, f32x4 (&x)[16], int wave, int lane) {
    const GAS float* p = t.W + (size_t)(t.k0 + 16 * wave) * t.N + t.n0 + 4 * lane;
#pragma unroll
    for (int i = 0; i < 16; ++i) x[i] = *(const GAS f32x4*)(p + (size_t)i * t.N);
}
__device__ __forceinline__ void conv_tile_stage(const WTile& t, const f32x4 (&x)[16], LAS unsigned* L, int wave, int lane) {
    if (t.kind == 0) {
#pragma unroll
        for (int p = 0; p < 8; ++p)
#pragma unroll
            for (int e = 0; e < 4; ++e) L[(lane + 64 * e) * 65 + 8 * wave + p] = pk2(x[2 * p][e], x[2 * p + 1][e]);
    } else {
        const float sc = t.sc;
#pragma unroll
        for (int q = 0; q < 4; ++q)
#pragma unroll
            for (int e = 0; e < 4; ++e) L[(lane + 64 * e) * 33 + 4 * wave + q] = pk4_fp8(x[4 * q][e] * sc, x[4 * q + 1][e] * sc, x[4 * q + 2][e] * sc, x[4 * q + 3][e] * sc);
    }
}
__device__ __forceinline__ void conv_tile_store(const WTile& t, const LAS unsigned* L, int wave, int lane) {
    if (t.kind == 0) {
        const int c = lane & 15, rs = lane >> 4;
#pragma unroll 2
        for (int r = 0; r < 8; ++r) { const int np = 32 * wave + 4 * r + rs, n = 4 * (np & 63) + (np >> 6) + t.n0 - t.nsub;
            const LAS unsigned* p = L + np * 65 + 4 * c; v4u o; o.x = p[0]; o.y = p[1]; o.z = p[2]; o.w = p[3];
            *(GAS v4u*)(t.dst + ((size_t)n * t.K + t.k0) * 2 + 16 * c) = o; }
    } else {
        const int c = lane & 7, rs = lane >> 3;
#pragma unroll 2
        for (int r = 0; r < 4; ++r) { const int np = 32 * wave + 8 * r + rs; int n = 4 * (np & 63) + (np >> 6) + t.n0 - t.nsub;
            if (t.rowmode) n = 256 * (n >> 7) + (n & 127) + (t.rowmode == 2 ? 128 : 0);
            const LAS unsigned* p = L + np * 33 + 4 * c; v4u o; o.x = p[0]; o.y = p[1]; o.z = p[2]; o.w = p[3];
            *(GAS v4u*)(t.dst + (size_t)n * t.K + t.k0 + 16 * c) = o; }
    }
}
constexpr int WT_IN = (D / 128) * (NIN / 256), WT_MKV = (D / 128) * (2048 / 256), WT_BR = (1024 / 128) * (D / 256), WT_OUT = (D / 128) * (D / 256), WT_GU = (D / 128) * (DFF / 256), WT_DN = (DFF / 128) * (D / 256);
constexpr int WT_EARLY = WT_IN + WT_MKV, WT_ALL = WT_EARLY + 3 * WT_BR + WT_OUT + NEXP * (2 * WT_GU + WT_DN);
static_assert(MOE1_FP8 && MOE2_FP8, "the tile converter writes the expert weights as e4m3");
__device__ __forceinline__ void conv_tiles(Ctx& C, const CAS Args* A_, int layer, int tb, int te, int wg, int nwg) {
    LAS unsigned* L = (LAS unsigned*)C.lds;
    const GAS float* w_in = ((const GAS float*)A_->in[5]) + (size_t)layer * D * NIN;
    const GAS float* w_mkv = ((const GAS float*)A_->in[14]) + (size_t)layer * D * 2048;
    const GAS float* w_br = ((const GAS float*)A_->in[15]) + (size_t)layer * 3 * 1024 * D;
    const GAS float* w_out = ((const GAS float*)A_->in[16]) + (size_t)layer * D * D;
    const GAS float* w_g = ((const GAS float*)A_->in[21]) + (size_t)layer * NEXP * D * DFF;
    const GAS float* w_u = ((const GAS float*)A_->in[22]) + (size_t)layer * NEXP * D * DFF;
    const GAS float* w_d = ((const GAS float*)A_->in[23]) + (size_t)layer * NEXP * DFF * D;
    GAS unsigned char* ws = C.ws;
    auto decode = [&](int ti, WTile& t) {
        int r = ti, nbk;
        if (r >= WT_ALL) { r -= WT_ALL;
            const GAS float* w_in2 = w_in + (size_t)D * NIN; const GAS float* w_mkv2 = w_mkv + (size_t)D * 2048;
            if (r < WT_IN) { nbk = NIN / 256; const int nb = r % nbk; const bool f8 = nb >= 8; t = WTile{w_in2, ws + (f8 ? WS_WG8 : WS_WIN), D, NIN, f8 ? 1 : 0, 0, f8 ? 2048 : 0, 128 * (r / nbk), 256 * nb, WG8_SCALE}; return; } r -= WT_IN;
            nbk = 8; t = WTile{w_mkv2, ws + WS_WMKV, D, 2048, 0, 0, 0, 128 * (r / nbk), 256 * (r % nbk), 1.f}; return; }
        if (r < WT_IN) { nbk = NIN / 256; const int nb = r % nbk; const bool f8 = nb >= 8; t = WTile{w_in, ws + (f8 ? WS_WG8 : WS_WIN), D, NIN, f8 ? 1 : 0, 0, f8 ? 2048 : 0, 128 * (r / nbk), 256 * nb, WG8_SCALE}; return; } r -= WT_IN;
        if (r < WT_MKV) { nbk = 8; t = WTile{w_mkv, ws + WS_WMKV, D, 2048, 0, 0, 0, 128 * (r / nbk), 256 * (r % nbk), 1.f}; return; } r -= WT_MKV;
        if (r < 3 * WT_BR) { const int n = r / WT_BR; r -= n * WT_BR; nbk = 8; t = WTile{w_br + (size_t)n * 1024 * D, ws + WS_WBR + (n == 0 ? 0 : (size_t)(n + 1) * D * 1024), 1024, D, n == 0 ? 0 : 1, 0, 0, 128 * (r / nbk), 256 * (r % nbk), WBR8_SCALE}; return; } r -= 3 * WT_BR;
        if (r < WT_OUT) { nbk = 8; t = WTile{w_out, ws + WS_WOUT, D, D, layer == NLAYER - 1 ? 1 : 0, 0, 0, 128 * (r / nbk), 256 * (r % nbk), WOUT8_SCALE}; return; } r -= WT_OUT;
        if (r < NEXP * WT_GU) { const int e = r / WT_GU; r -= e * WT_GU; nbk = 2; t = WTile{w_g + (size_t)e * D * DFF, ws + WS_WGU + (size_t)e * 1024 * D, D, DFF, 1, 1, 0, 128 * (r / nbk), 256 * (r % nbk), WGU8_SCALE}; return; } r -= NEXP * WT_GU;
        if (r < NEXP * WT_GU) { const int e = r / WT_GU; r -= e * WT_GU; nbk = 2; t = WTile{w_u + (size_t)e * D * DFF, ws + WS_WGU + (size_t)e * 1024 * D, D, DFF, 1, 2, 0, 128 * (r / nbk), 256 * (r % nbk), WGU8_SCALE}; return; } r -= NEXP * WT_GU;
        { const int e = r / WT_DN; r -= e * WT_DN; nbk = 8; t = WTile{w_d + (size_t)e * DFF * D, ws + WS_WD + (size_t)e * D * DFF, DFF, D, 1, 0, 0, 128 * (r / nbk), 256 * (r % nbk), WD8_SCALE}; }
    };
    int ti = tb + wg; if (ti >= te) return;
    WTile cur, nxt; f32x4 x[16]; decode(ti, cur); conv_tile_load(cur, x, C.wave, C.lane);
    for (;;) {
        conv_tile_stage(cur, x, L, C.wave, C.lane);
        const int tn = ti + nwg; const bool has = tn < te;
        if (has) { decode(tn, nxt); conv_tile_load(nxt, x, C.wave, C.lane); }
        __syncthreads();
        conv_tile_store(cur, L, C.wave, C.lane);
        __syncthreads();
        if (!has) break;
        cur = nxt; ti = tn;
    }
}
__device__ __forceinline__ void phase_prep(Ctx& C, const CAS Args* A_, int layer, bool late, int gw, int NGW) {
    if (late) { conv_tiles(C, A_, layer, WT_EARLY, WT_ALL + (layer + 1 < NLAYER ? WT_EARLY : 0), C.vcu, C.G); return; }
    if (!LATE_PCT) conv_tiles(C, A_, layer, 0, WT_ALL, C.vcu, C.G);
    else if (layer == 0) conv_tiles(C, A_, layer, 0, WT_EARLY, C.vcu, C.G);
    {
        const GAS float* g2 = ((const GAS float*)A_->in[4]) + layer * D; const GAS float* wrg = ((const GAS float*)A_->in[17]) + (size_t)layer * D * 4; const GAS float* wre = ((const GAS float*)A_->in[19]) + (size_t)layer * D * 16;
        GAS float* wrt = (GAS float*)((GAS unsigned*)C.ctl + CW_WRT);
        for (int i = gw * 64 + C.lane; i < 20 * D; i += NGW * 64) { const int n = i / D, k = i - n * D; wrt[i] = (n < 16 ? wre[(size_t)k * 16 + n] : wrg[(size_t)k * 4 + (n - 16)]) * g2[k]; }
    }
    GAS bf16* H = (GAS bf16*)(C.ws + WS_H); GAS bf16* MemH = (GAS bf16*)(C.ws + WS_MEMH);
    if (layer == 0) { const GAS float* xin = (const GAS float*)A_->in[0];
        for (int m = gw; m < T; m += NGW) rms_row_to_bf16(xin + (size_t)m * D, ((const GAS float*)A_->in[2]) + layer * D, H + (size_t)m * D, C.lane, (GAS unsigned char*)(C.ws + WS_H8) + (size_t)m * D); }
    else { const GAS bf16* xb = (const GAS bf16*)(C.ws + WS_XB);
        for (int m = gw; m < T; m += NGW) rms_row_from_bf16(xb + (size_t)m * D, ((const GAS float*)A_->in[2]) + layer * D, H + (size_t)m * D, C.lane, (GAS unsigned char*)(C.ws + WS_H8) + (size_t)m * D); }
    for (int m = gw; m < MEMT; m += NGW) rms_row_to_bf16(((const GAS float*)A_->in[1]) + (size_t)m * D, ((const GAS float*)A_->in[3]) + layer * D, MemH + (size_t)m * D, C.lane);
}

typedef float f32x4_t __attribute__((ext_vector_type(4)));
__device__ __forceinline__ bf16x8 ld_lds16(const LAS bf16* p) { return *(const LAS bf16x8*)p; }
__device__ __forceinline__ bf16x8 ld_lds8x2(const LAS bf16* p0, const LAS bf16* p1) {
    const v2u a = *(const LAS v2u*)p0, b = *(const LAS v2u*)p1; v4u w; w.x = a.x; w.y = a.y; w.z = b.x; w.w = b.y; return __builtin_bit_cast(bf16x8, w);
}
__device__ __forceinline__ float quad_sum(float v, int lane) { v += shx(v, 16, lane); v += shx(v, 32, lane); return v; }
__device__ __forceinline__ float quad_max(float v, int lane) { v = fmaxf(v, shx(v, 16, lane)); v = fmaxf(v, shx(v, 32, lane)); return v; }
#define MFMA16(a, b, c) __builtin_amdgcn_mfma_f32_16x16x32_bf16((a), (b), (c), 0, 0, 0)
typedef short v4i16_t __attribute__((ext_vector_type(4)));
__device__ __forceinline__ bf16x8 ld_tr2(const LAS bf16* base, int pitch, int rowA, int rowB, int col0, int lane) {
    const int q = (lane & 15) >> 2, p = lane & 3;
    const v4i16_t a = __builtin_amdgcn_ds_read_tr16_b64_v4i16((LAS v4i16_t*)(base + (rowA + q) * pitch + col0 + 4 * p));
    const v4i16_t b = __builtin_amdgcn_ds_read_tr16_b64_v4i16((LAS v4i16_t*)(base + (rowB + q) * pitch + col0 + 4 * p));
    bf16x8 r; r[0] = a[0]; r[1] = a[1]; r[2] = a[2]; r[3] = a[3]; r[4] = b[0]; r[5] = b[1]; r[6] = b[2]; r[7] = b[3]; return r;
}

constexpr int VA_PITCH = 144;
struct ARaw { unsigned xv[16]; f32x2 gv; f32x4 wf[4][2]; v2u uu[8]; float bt; };
__device__ __forceinline__ void mixer_a_load(Ctx& C, const CAS Args* A_, int layer, int unit, ARaw& R) {
    const int g = unit & 7, bn = unit >> 3;
    const GAS bf16* P1 = (const GAS bf16*)(C.ws + WS_P1);
    const GAS float* vgain = ((const GAS float*)A_->in[6]) + (layer * 8 + g) * 128; const GAS float* Wsp = ((const GAS float*)A_->in[7]) + (size_t)(layer * 8 + g) * 128 * 128; const GAS float* bsp = ((const GAS float*)A_->in[8]) + (layer * 8 + g) * 128;
    const int lane = C.lane, fr = lane & 15, fq = lane >> 4, w = C.wave, t = 16 * w + fr; const size_t row = (size_t)(bn * 128 + t);
#pragma unroll
    for (int i = 0; i < 16; ++i) R.xv[i] = *(const GAS unsigned*)(P1 + (size_t)(bn * 128 + 16 * w + i) * 2048 + 1024 + g * 128 + 2 * lane);
    R.gv = *(const GAS f32x2*)(vgain + 2 * lane);
#pragma unroll
    for (int ks = 0; ks < 4; ++ks) { R.wf[ks][0] = *(const GAS f32x4*)(Wsp + t * 128 + 32 * ks + 8 * fq); R.wf[ks][1] = *(const GAS f32x4*)(Wsp + t * 128 + 32 * ks + 8 * fq + 4); }
#pragma unroll
    for (int ct = 0; ct < 8; ++ct) R.uu[ct] = *(const GAS v2u*)(P1 + row * 2048 + g * 128 + 16 * ct + 4 * fq);
    R.bt = bsp[t];
}
__device__ __forceinline__ void mixer_a_compute(Ctx& C, int unit, const ARaw& R) {
    const int g = unit & 7, bn = unit >> 3;
    GAS bf16* Y = (GAS bf16*)(C.ws + WS_Y);
    LAS bf16* Vn = (LAS bf16*)C.lds;
    const int lane = C.lane, fr = lane & 15, fq = lane >> 4, w = C.wave;
    const int t = 16 * w + fr;
    const size_t row = (size_t)(bn * 128 + t);
    __syncthreads();
#pragma unroll
    for (int i = 0; i < 16; ++i) { const float a = bflo(R.xv[i]), b = bfhi(R.xv[i]);
        const float rstd = 1.f / sqrtf(wave_sum(a * a + b * b, lane) * (1.f / 128) + EPS);
        *(LAS unsigned*)(Vn + (16 * w + i) * VA_PITCH + 2 * lane) = pk2(a * rstd * R.gv[0], b * rstd * R.gv[1]); }
    __syncthreads();
    f32x4 acc[8];
#pragma unroll
    for (int ct = 0; ct < 8; ++ct) acc[ct] = (f32x4){C.zf, C.zf, C.zf, C.zf};
#pragma unroll
    for (int ks = 0; ks < 4; ++ks) {
        const int s0 = 32 * ks + 8 * fq; const f32x4 w0 = R.wf[ks][0], w1 = R.wf[ks][1];
        v4u wb; wb.x = pk2(s0 + 0 <= t ? w0[0] : 0.f, s0 + 1 <= t ? w0[1] : 0.f); wb.y = pk2(s0 + 2 <= t ? w0[2] : 0.f, s0 + 3 <= t ? w0[3] : 0.f);
        wb.z = pk2(s0 + 4 <= t ? w1[0] : 0.f, s0 + 5 <= t ? w1[1] : 0.f); wb.w = pk2(s0 + 6 <= t ? w1[2] : 0.f, s0 + 7 <= t ? w1[3] : 0.f);
        const bf16x8 bfrag = __builtin_bit_cast(bf16x8, wb);
        if (32 * ks <= 16 * w + 15) {
#pragma unroll
            for (int ct = 0; ct < 8; ++ct) acc[ct] = MFMA16(ld_tr2(Vn, VA_PITCH, 32 * ks + 8 * fq, 32 * ks + 8 * fq + 4, 16 * ct, lane), bfrag, acc[ct]); }
    }
    const float bt = R.bt;
#pragma unroll
    for (int ct = 0; ct < 8; ++ct) {
        const int c = 16 * ct + 4 * fq;
        v2u o; o.x = pk2(bflo(R.uu[ct].x) * (acc[ct][0] + bt), bfhi(R.uu[ct].x) * (acc[ct][1] + bt)); o.y = pk2(bflo(R.uu[ct].y) * (acc[ct][2] + bt), bfhi(R.uu[ct].y) * (acc[ct][3] + bt));
        *(GAS v2u*)(Y + row * 3072 + g * 128 + c) = o;
    }
}
constexpr int KB_PITCH = 72, VB_PITCH = 80;
struct BRaw { v4u qx[4][2]; v2u kx[8], vx[8]; float sink4[4]; };
struct BGain { f32x4 gq0[2], gq1[2], kg4; };
__device__ __forceinline__ void mixer_b_load(Ctx& C, const CAS Args* A_, int layer, int unit, BRaw& R) {
    const int hk = unit & 3, bn = unit >> 2, n = bn & 31;
    const GAS bf16* P2 = (const GAS bf16*)(C.ws + WS_P2);
    const GAS float* sinks = ((const GAS float*)A_->in[11]) + layer * 16;
    const int lane = C.lane, fr = lane & 15, fq = lane >> 4, w = C.wave, rg = lane >> 4, dc = lane & 15;
    const size_t row = (size_t)bn * 128 + 16 * w + fr;
#pragma unroll
    for (int qh = 0; qh < 4; ++qh)
#pragma unroll
        for (int ks = 0; ks < 2; ++ks) R.qx[qh][ks] = *(const GAS v4u*)(P2 + row * 1536 + (hk * 4 + qh) * 64 + 32 * ks + 8 * fq);
#pragma unroll
    for (int it = 0; it < 8; ++it) { const int kj = 32 * w + 4 * it + rg; const bool ok = (n > 0 || kj >= 128);
        const size_t r2 = ok ? (size_t)bn * 128 - 128 + kj : (size_t)bn * 128;
        R.kx[it] = *(const GAS v2u*)(P2 + r2 * 1536 + 1024 + hk * 64 + 4 * dc); R.vx[it] = *(const GAS v2u*)(P2 + r2 * 1536 + 1280 + hk * 64 + 4 * dc);
        if (!ok) { R.kx[it] = (v2u){0u, 0u}; R.vx[it] = (v2u){0u, 0u}; } }
#pragma unroll
    for (int qh = 0; qh < 4; ++qh) R.sink4[qh] = sinks[hk * 4 + qh];
}
__device__ __forceinline__ void mixer_b_gains(Ctx& C, const CAS Args* A_, int layer, BGain& G) {
    const GAS float* qg = ((const GAS float*)A_->in[9]) + layer * 64; const GAS float* kg = ((const GAS float*)A_->in[10]) + layer * 64; const int fq = C.lane >> 4, dc = C.lane & 15;
#pragma unroll
    for (int ks = 0; ks < 2; ++ks) { G.gq0[ks] = *(const GAS f32x4*)(qg + 32 * ks + 8 * fq); G.gq1[ks] = *(const GAS f32x4*)(qg + 32 * ks + 8 * fq + 4); }
    G.kg4 = *(const GAS f32x4*)(kg + 4 * dc);
}
__device__ __forceinline__ void mixer_b_compute(Ctx& C, const CAS Args* A_, int layer, int unit, BRaw& R, const BGain& G, bool has_next, int next_unit) {
    const int hk = unit & 3, bn = unit >> 2, n = bn & 31;
    GAS bf16* Y = (GAS bf16*)(C.ws + WS_Y);
    LAS bf16* Ks = (LAS bf16*)C.lds;
    LAS bf16* Vs = Ks + 256 * KB_PITCH;
    const int lane = C.lane, fr = lane & 15, fq = lane >> 4, w = C.wave;
    const int qi = 16 * w + fr; const size_t row = (size_t)bn * 128 + qi;
    bf16x8 qfa[4][2]; float sink4[4];
    {
        float gq[2][8];
#pragma unroll
        for (int ks = 0; ks < 2; ++ks)
#pragma unroll
            for (int e = 0; e < 4; ++e) { gq[ks][e] = G.gq0[ks][e]; gq[ks][4 + e] = G.gq1[ks][e]; }
#pragma unroll
        for (int qh = 0; qh < 4; ++qh) sink4[qh] = R.sink4[qh];
#pragma unroll
        for (int qh = 0; qh < 4; ++qh) {
            float qv[2][8]; float ss = 0.f;
#pragma unroll
            for (int ks = 0; ks < 2; ++ks) { const v4u x = R.qx[qh][ks];
                qv[ks][0] = bflo(x.x); qv[ks][1] = bfhi(x.x); qv[ks][2] = bflo(x.y); qv[ks][3] = bfhi(x.y); qv[ks][4] = bflo(x.z); qv[ks][5] = bfhi(x.z); qv[ks][6] = bflo(x.w); qv[ks][7] = bfhi(x.w);
#pragma unroll
                for (int e = 0; e < 8; ++e) ss += qv[ks][e] * qv[ks][e]; }
            const float qr = 0.125f / sqrtf(quad_sum(ss, lane) * (1.f / 64) + EPS);
#pragma unroll
            for (int ks = 0; ks < 2; ++ks) { v4u p;
                p.x = pk2(qv[ks][0] * qr * gq[ks][0], qv[ks][1] * qr * gq[ks][1]); p.y = pk2(qv[ks][2] * qr * gq[ks][2], qv[ks][3] * qr * gq[ks][3]);
                p.z = pk2(qv[ks][4] * qr * gq[ks][4], qv[ks][5] * qr * gq[ks][5]); p.w = pk2(qv[ks][6] * qr * gq[ks][6], qv[ks][7] * qr * gq[ks][7]); qfa[qh][ks] = __builtin_bit_cast(bf16x8, p); }
        }
    }
    __syncthreads();
    {
        const int rg = lane >> 4, dc = lane & 15;
        const f32x4 kg4 = G.kg4;
#pragma unroll
        for (int it = 0; it < 8; ++it) { const int kj = 32 * w + 4 * it + rg;
            const float a0 = bflo(R.kx[it].x), a1 = bfhi(R.kx[it].x), a2 = bflo(R.kx[it].y), a3 = bfhi(R.kx[it].y);
            float ss = (a0 * a0 + a1 * a1) + (a2 * a2 + a3 * a3);
            ss += shx(ss, 1, lane); ss += shx(ss, 2, lane); ss += shx(ss, 4, lane); ss += shx(ss, 8, lane);
            const float rstd = 1.f / sqrtf(ss * (1.f / 64) + EPS);
            v2u o; o.x = pk2(a0 * rstd * kg4[0], a1 * rstd * kg4[1]); o.y = pk2(a2 * rstd * kg4[2], a3 * rstd * kg4[3]);
            *(LAS v2u*)(Ks + kj * KB_PITCH + 4 * dc) = o; *(LAS v2u*)(Vs + kj * VB_PITCH + 4 * dc) = R.vx[it]; }
    }
    __syncthreads();
    if (has_next) mixer_b_load(C, A_, layer, next_unit, R);
#pragma unroll
    for (int qh = 0; qh < 4; ++qh) {
        const int h = hk * 4 + qh;
        int ldo = 0; asm volatile("" : "+v"(ldo));
        const LAS bf16* Ksl = Ks + ldo; const LAS bf16* Vsl = Vs + ldo;
        bf16x8 qf[2]; qf[0] = qfa[qh][0]; qf[1] = qfa[qh][1];
        f32x4 sc[9];
#pragma unroll
        for (int kt = 0; kt < 9; ++kt) { sc[kt] = (f32x4){C.zf, C.zf, C.zf, C.zf};
#pragma unroll
            for (int ks = 0; ks < 2; ++ks) sc[kt] = MFMA16(ld_lds16(Ksl + (16 * (w + kt) + fr) * KB_PITCH + 32 * ks + 8 * fq), qf[ks], sc[kt]); }
        const float sink = sink4[qh]; float mx = sink;
#pragma unroll
        for (int kt = 0; kt < 9; ++kt)
#pragma unroll
            for (int r = 0; r < 4; ++r) { const int kj = 16 * (w + kt) + 4 * fq + r; const bool ok = (kj > qi) && (kj <= qi + 128) && (n > 0 || kj >= 128);
                sc[kt][r] = ok ? sc[kt][r] : -3.0e38f; mx = fmaxf(mx, sc[kt][r]); }
        mx = quad_max(mx, lane); float l = 0.f;
#pragma unroll
        for (int kt = 0; kt < 9; ++kt)
#pragma unroll
            for (int r = 0; r < 4; ++r) { const float p = (sc[kt][r] > -1.0e38f) ? __expf(sc[kt][r] - mx) : 0.f; sc[kt][r] = p; l += p; }
        l = quad_sum(l, lane) + __expf(sink - mx);
        const float inv = 1.f / l;
        f32x4 oc[4];
#pragma unroll
        for (int dt = 0; dt < 4; ++dt) oc[dt] = (f32x4){C.zf, C.zf, C.zf, C.zf};
#pragma unroll
        for (int pr = 0; pr < 5; ++pr) {
            const int t0 = w + 2 * pr, t1r = w + 2 * pr + 1; const bool has1 = (2 * pr + 1) < 9; const int t1 = t1r > 15 ? 15 : t1r;
            v4u pb; pb.x = pk2(sc[2 * pr][0], sc[2 * pr][1]); pb.y = pk2(sc[2 * pr][2], sc[2 * pr][3]);
            if (has1) { pb.z = pk2(sc[has1 ? 2 * pr + 1 : 0][0], sc[has1 ? 2 * pr + 1 : 0][1]); pb.w = pk2(sc[has1 ? 2 * pr + 1 : 0][2], sc[has1 ? 2 * pr + 1 : 0][3]); } else { pb.z = 0u; pb.w = 0u; }
            const bf16x8 pfrag = __builtin_bit_cast(bf16x8, pb);
#pragma unroll
            for (int dt = 0; dt < 4; ++dt) oc[dt] = MFMA16(ld_tr2(Vsl, VB_PITCH, 16 * t0 + 4 * fq, 16 * t1 + 4 * fq, 16 * dt, lane), pfrag, oc[dt]);
        }
#pragma unroll
        for (int dt = 0; dt < 4; ++dt) { const float i8 = inv * YBC8_SCALE; unsigned ro = (unsigned)row * 6144u + (unsigned)(2048 + h * 64 + 4 * fq); asm volatile("" : "+v"(ro));
            *(GAS unsigned*)((GAS unsigned char*)Y + ro + 16 * dt) = pk4_fp8(oc[dt][0] * i8, oc[dt][1] * i8, oc[dt][2] * i8, oc[dt][3] * i8); }
    }
}
constexpr int KC_PITCH = 264, VC_PITCH = 272;
struct CRaw { v2u kx[16]; v4u qx[8]; };
__device__ __forceinline__ void mixer_c_load(Ctx& C, int unit, CRaw& R) {
    const int h = unit & 3, qt = unit >> 2, b = qt >> 5;
    const GAS bf16* P3 = (const GAS bf16*)(C.ws + WS_P3); const GAS bf16* KVM = (const GAS bf16*)(C.ws + WS_KVM);
    const int lane = C.lane, fr = lane & 15, fq = lane >> 4, w = C.wave; const size_t row = (size_t)qt * 128 + 16 * w + fr;
#pragma unroll
    for (int i = 0; i < 16; ++i) R.kx[i] = *(const GAS v2u*)(KVM + (size_t)(b * 256 + 32 * w + i) * 2048 + h * 256 + 4 * lane);
#pragma unroll
    for (int ks = 0; ks < 8; ++ks) R.qx[ks] = *(const GAS v4u*)(P3 + row * 1024 + h * 256 + 32 * ks + 8 * fq);
}
__device__ __forceinline__ void mixer_c_compute(Ctx& C, int unit, CRaw& R, f32x4 cg4, bool has_next, int next_unit) {
    const int h = unit & 3, qt = unit >> 2, b = qt >> 5;
    const GAS bf16* KVM = (const GAS bf16*)(C.ws + WS_KVM); GAS bf16* Y = (GAS bf16*)(C.ws + WS_Y);
    LAS bf16* KV = (LAS bf16*)C.lds;
    const int lane = C.lane, fr = lane & 15, fq = lane >> 4, w = C.wave;
    v2u kx2[16];
#pragma unroll
    for (int i = 0; i < 16; ++i) kx2[i] = *(const GAS v2u*)(KVM + (size_t)(b * 256 + 32 * w + 16 + i) * 2048 + h * 256 + 4 * lane);
    __syncthreads();
#pragma unroll
    for (int i = 0; i < 32; ++i) {
        const v2u kxi = i < 16 ? R.kx[i & 15] : kx2[i & 15];
        const float a0 = bflo(kxi.x), a1 = bfhi(kxi.x), a2 = bflo(kxi.y), a3 = bfhi(kxi.y);
        const float rstd = 1.f / sqrtf(wave_sum(a0 * a0 + a1 * a1 + a2 * a2 + a3 * a3, lane) * (1.f / 256) + EPS);
        v2u o; o.x = pk2(a0 * rstd * cg4[0], a1 * rstd * cg4[1]); o.y = pk2(a2 * rstd * cg4[2], a3 * rstd * cg4[3]);
        *(LAS v2u*)(KV + (32 * w + i) * KC_PITCH + 4 * lane) = o; if ((i & 7) == 7) asm volatile("" ::: "memory"); }
    __syncthreads();
    const size_t row = (size_t)qt * 128 + 16 * w + fr;
    bf16x8 pf[8];
    {
        bf16x8 qf[8];
        {
            float ss = 0.f;
#pragma unroll
            for (int ks = 0; ks < 8; ++ks) { const v4u x = R.qx[ks];
                const float e0 = bflo(x.x), e1 = bfhi(x.x), e2 = bflo(x.y), e3 = bfhi(x.y), e4 = bflo(x.z), e5 = bfhi(x.z), e6 = bflo(x.w), e7 = bfhi(x.w);
                ss += (e0 * e0 + e1 * e1) + (e2 * e2 + e3 * e3) + (e4 * e4 + e5 * e5) + (e6 * e6 + e7 * e7); }
            const float qr = 0.0625f / sqrtf(quad_sum(ss, lane) * (1.f / 256) + EPS);
#pragma unroll
            for (int ks = 0; ks < 8; ++ks) { const v4u x = R.qx[ks]; v4u p;
                p.x = pk2(bflo(x.x) * qr, bfhi(x.x) * qr); p.y = pk2(bflo(x.y) * qr, bfhi(x.y) * qr); p.z = pk2(bflo(x.z) * qr, bfhi(x.z) * qr); p.w = pk2(bflo(x.w) * qr, bfhi(x.w) * qr);
                qf[ks] = __builtin_bit_cast(bf16x8, p); }
        }
        f32x4 sc[16];
#pragma unroll
        for (int mt = 0; mt < 16; ++mt) { sc[mt] = (f32x4){C.zf, C.zf, C.zf, C.zf};
#pragma unroll
            for (int ks = 0; ks < 8; ++ks) sc[mt] = MFMA16(ld_lds16(KV + (16 * mt + fr) * KC_PITCH + 32 * ks + 8 * fq), qf[ks], sc[mt]);
            asm volatile("" ::: "memory"); }
        float mx = -3.0e38f;
#pragma unroll
        for (int mt = 0; mt < 16; ++mt) mx = fmaxf(fmaxf(mx, fmaxf(sc[mt][0], sc[mt][1])), fmaxf(sc[mt][2], sc[mt][3]));
        mx = quad_max(mx, lane); float l = 0.f;
#pragma unroll
        for (int mt = 0; mt < 16; ++mt)
#pragma unroll
            for (int r = 0; r < 4; ++r) { sc[mt][r] = __expf(sc[mt][r] - mx); l += sc[mt][r]; }
        const float inv = 1.f / quad_sum(l, lane);
#pragma unroll
        for (int pr = 0; pr < 8; ++pr) { v4u pb; pb.x = pk2(sc[2 * pr][0] * inv, sc[2 * pr][1] * inv); pb.y = pk2(sc[2 * pr][2] * inv, sc[2 * pr][3] * inv);
            pb.z = pk2(sc[2 * pr + 1][0] * inv, sc[2 * pr + 1][1] * inv); pb.w = pk2(sc[2 * pr + 1][2] * inv, sc[2 * pr + 1][3] * inv); pf[pr] = __builtin_bit_cast(bf16x8, pb); }
    }
    v2u vx[16], vx2[16];
#pragma unroll
    for (int i = 0; i < 16; ++i) { vx[i] = *(const GAS v2u*)(KVM + (size_t)(b * 256 + 32 * w + i) * 2048 + 1024 + h * 256 + 4 * lane); vx2[i] = *(const GAS v2u*)(KVM + (size_t)(b * 256 + 32 * w + 16 + i) * 2048 + 1024 + h * 256 + 4 * lane); }
    __syncthreads();
#pragma unroll
    for (int i = 0; i < 16; ++i) *(LAS v2u*)(KV + (32 * w + i) * VC_PITCH + 4 * lane) = vx[i];
#pragma unroll
    for (int i = 0; i < 16; ++i) *(LAS v2u*)(KV + (32 * w + 16 + i) * VC_PITCH + 4 * lane) = vx2[i];
    __syncthreads();
    if (has_next) mixer_c_load(C, next_unit, R);
#pragma unroll 4
    for (int dt = 0; dt < 16; ++dt) {
        f32x4 oc = (f32x4){C.zf, C.zf, C.zf, C.zf};
#pragma unroll
        for (int pr = 0; pr < 8; ++pr) oc = MFMA16(ld_tr2(KV, VC_PITCH, 32 * pr + 4 * fq, 32 * pr + 16 + 4 * fq, 16 * dt, lane), pf[pr], oc);
        asm volatile("" ::: "memory");
        unsigned ro = (unsigned)row * 6144u + (unsigned)(3072 + h * 256 + 4 * fq); asm volatile("" : "+v"(ro));
        *(GAS unsigned*)((GAS unsigned char*)Y + ro + 16 * dt) = pk4_fp8(oc[0] * YBC8_SCALE, oc[1] * YBC8_SCALE, oc[2] * YBC8_SCALE, oc[3] * YBC8_SCALE);
    }
}
__device__ __forceinline__ void phase_mix(Ctx& C, const CAS Args* A_, int layer, int conv_slot) {
    constexpr int NA = NB * 32 * 8, NBU = NB * 32 * 4, NC = (T / 128) * 4;
#ifndef MIXSEL
#define MIXSEL 7
#endif
#ifndef MIXREP
#define MIXREP 0
#endif
    if (conv_slot == 0) { __syncthreads(); phase_prep(C, A_, layer, true, C.vcu * NWAVES + C.wave, C.G * NWAVES); __syncthreads(); relaunder(C); asm volatile("" : "+s"(A_)); }
    for (int rp = 0; rp < ((MIXREP & 1) ? 2 : 1); ++rp) {
        int u = C.vcu; ARaw R0, R1; if (u < NA) mixer_a_load(C, A_, layer, u, R0);
        while (u < NA) { const int un = u + C.G; if (un < NA) mixer_a_load(C, A_, layer, un, R1); mixer_a_compute(C, u, R0); R0 = R1; u = un; } }
    if (conv_slot == 1) { __syncthreads(); phase_prep(C, A_, layer, true, C.vcu * NWAVES + C.wave, C.G * NWAVES); __syncthreads(); relaunder(C); asm volatile("" : "+s"(A_)); }
    for (int rp = 0; rp < ((MIXREP & 2) ? 2 : 1); ++rp) {
        int u = C.vcu; BRaw R0; BGain BG; mixer_b_gains(C, A_, layer, BG); if (u < NBU) mixer_b_load(C, A_, layer, u, R0);
        while (u < NBU) { const int un = u + C.G; mixer_b_compute(C, A_, layer, u, R0, BG, un < NBU, un); u = un; } }
    if (conv_slot == 2) { __syncthreads(); phase_prep(C, A_, layer, true, C.vcu * NWAVES + C.wave, C.G * NWAVES); __syncthreads(); relaunder(C); asm volatile("" : "+s"(A_)); }
    for (int rp = 0; rp < ((MIXREP & 4) ? 2 : 1); ++rp) {
        const GAS float* qg = ((const GAS float*)A_->in[12]) + layer * 256; const GAS float* kg = ((const GAS float*)A_->in[13]) + layer * 256;
        const f32x4 cg4 = *(const GAS f32x4*)(kg + 4 * C.lane) * *(const GAS f32x4*)(qg + 4 * C.lane);
        int u = C.vcu; CRaw R0; if (u < NC) mixer_c_load(C, u, R0);
        while (u < NC) { const int un = u + C.G; mixer_c_compute(C, u, R0, cg4, un < NC, un); u = un; } }
    __syncthreads();
}

__device__ __forceinline__ void phase_route(Ctx& C, const CAS Args* A_, int layer) {
    const GAS float* gain = ((const GAS float*)A_->in[4]) + layer * D; const GAS float* wrg = ((const GAS float*)A_->in[17]) + (size_t)layer * D * 4; const GAS float* brg = ((const GAS float*)A_->in[18]) + layer * 4;
    const GAS float* wre = ((const GAS float*)A_->in[19]) + (size_t)layer * D * 16; const GAS float* bre = ((const GAS float*)A_->in[20]) + layer * 16;
    GAS bf16* H = (GAS bf16*)(C.ws + WS_H); GAS int* perm2 = (GAS int*)(C.ws + WS_PERM2); GAS float* roww2 = (GAS float*)(C.ws + WS_ROWW2);
    GAS unsigned* cnt = (GAS unsigned*)C.ctl + CW_CNT + layer * 32;
    LAS float* part = (LAS float*)C.lds;
    LAS float* rs = part + 16 * 64 * 24;
    const int lane = C.lane, w = C.wave, kq = lane >> 4, j = lane & 15;
    for (int blk = C.vcu; blk < T / 64; blk += C.G) {
        const int t0 = blk * 64;
        __syncthreads();
#pragma unroll 1
        for (int hf = 0; hf < 2; ++hf) {
    const int kbase = 256 * w + 128 * hf;
    float Be[4][8], Bg[4][8]; f32x4 gs[4][2];
    const GAS float* wrt = (const GAS float*)((GAS unsigned*)C.ctl + CW_WRT);
    const GAS f32x4* gp4 = (const GAS f32x4*)(gain + kbase + 8 * kq); const GAS f32x4* wep4 = (const GAS f32x4*)(wrt + (size_t)j * D + kbase + 8 * kq); const GAS f32x4* wgp4 = (const GAS f32x4*)(wrt + (size_t)(16 + (j & 3)) * D + kbase + 8 * kq);
#pragma unroll
    for (int s = 0; s < 4; ++s) { gs[s][0] = gp4[0]; gs[s][1] = gp4[1]; const f32x4 ea = wep4[0], eb = wep4[1], ga = wgp4[0], gb = wgp4[1];
#pragma unroll
        for (int e = 0; e < 4; ++e) { Be[s][e] = ea[e]; Bg[s][e] = ga[e]; Be[s][4 + e] = eb[e]; Bg[s][4 + e] = gb[e]; }
        gp4 += 8; wep4 += 8; wgp4 += 8; asm volatile("" : "+v"(gp4), "+v"(wep4), "+v"(wgp4)); }
    if (j >= 4) {
#pragma unroll
        for (int s = 0; s < 4; ++s)
#pragma unroll
            for (int e = 0; e < 8; ++e) Bg[s][e] = 0.f; }
#pragma unroll 1
        for (int tt = 0; tt < 4; ++tt) {
            const GAS bf16* xp = (const GAS bf16*)(C.ws + WS_XB) + (size_t)(t0 + 16 * tt + j) * D + kbase + 8 * kq; GAS unsigned char* hp = (GAS unsigned char*)(C.ws + WS_H8) + (size_t)(t0 + 16 * tt + j) * D + kbase + 8 * kq;
            f32x4 ae = (f32x4){C.zf, C.zf, C.zf, C.zf}, ag = (f32x4){C.zf, C.zf, C.zf, C.zf}; float ssq = 0.f;
            {
                v4u xr[4];
#pragma unroll
                for (int s = 0; s < 4; ++s) xr[s] = *(const GAS v4u*)(xp + 32 * s);
#pragma unroll
                for (int s = 0; s < 4; ++s) { const f32x4 xa = (f32x4){bflo(xr[s].x), bfhi(xr[s].x), bflo(xr[s].y), bfhi(xr[s].y)}, xb4 = (f32x4){bflo(xr[s].z), bfhi(xr[s].z), bflo(xr[s].w), bfhi(xr[s].w)};
                    ssq += ((xa[0] * xa[0] + xa[1] * xa[1]) + (xa[2] * xa[2] + xa[3] * xa[3])) + ((xb4[0] * xb4[0] + xb4[1] * xb4[1]) + (xb4[2] * xb4[2] + xb4[3] * xb4[3]));
                    const f32x4 ha = xa * gs[s][0], hb = xb4 * gs[s][1];
                    if (MOE1_FP8) *(GAS v2u*)(hp + 32 * s) = (v2u){pk4_fp8(ha[0], ha[1], ha[2], ha[3]), pk4_fp8(hb[0], hb[1], hb[2], hb[3])};
                    else *(GAS v4u*)(H + (size_t)(t0 + 16 * tt + j) * D + kbase + 8 * kq + 32 * s) = pack8(ha, hb);
#pragma unroll
                    for (int e = 0; e < 4; ++e) { ae = __builtin_amdgcn_mfma_f32_16x16x4f32(xa[e], Be[s][e], ae, 0, 0, 0); ag = __builtin_amdgcn_mfma_f32_16x16x4f32(xa[e], Bg[s][e], ag, 0, 0, 0); }
#pragma unroll
                    for (int e = 0; e < 4; ++e) { ae = __builtin_amdgcn_mfma_f32_16x16x4f32(xb4[e], Be[s][4 + e], ae, 0, 0, 0); ag = __builtin_amdgcn_mfma_f32_16x16x4f32(xb4[e], Bg[s][4 + e], ag, 0, 0, 0); } }
            }
            ssq += shx(ssq, 16, lane); ssq += shx(ssq, 32, lane);
            LAS float* pw = part + ((2 * w + hf) * 64 + 16 * tt) * 24;
#pragma unroll
            for (int r = 0; r < 4; ++r) { pw[(4 * kq + r) * 24 + j] = ae[r]; if (j < 4) pw[(4 * kq + r) * 24 + 16 + j] = ag[r]; }
            if (kq == 0) pw[j * 24 + 20] = ssq;
        }
        }
        __syncthreads();
        if (C.tid < 64) {
            const int t = t0 + C.tid;
            float lg[4], le[16]; float ssq = 0.f;
#pragma unroll
            for (int c = 0; c < 4; ++c) lg[c] = 0.f;
#pragma unroll
            for (int e = 0; e < 16; ++e) le[e] = 0.f;
#pragma unroll
            for (int ww = 0; ww < 16; ++ww) { const LAS float* p = part + (ww * 64 + C.tid) * 24;
#pragma unroll
                for (int e = 0; e < 16; ++e) le[e] += p[e];
#pragma unroll
                for (int c = 0; c < 4; ++c) lg[c] += p[16 + c];
                ssq += p[20]; }
            const float rstd = 1.f / sqrtf(ssq * (1.f / D) + EPS);
#pragma unroll
            for (int c = 0; c < 4; ++c) lg[c] = lg[c] * rstd + brg[c];
#pragma unroll
            for (int e = 0; e < 16; ++e) le[e] = le[e] * rstd + bre[e];
            int g = 0; float gm = lg[0];
#pragma unroll
            for (int c = 1; c < 4; ++c) if (lg[c] > gm) { gm = lg[c]; g = c; }
            float den = 0.f;
#pragma unroll
            for (int c = 0; c < 4; ++c) den += __expf(lg[c] - gm);
            const float pg = 1.f / den;
            float el[4] = {0.f, 0.f, 0.f, 0.f};
#pragma unroll
            for (int c = 0; c < 4; ++c)
#pragma unroll
                for (int jj = 0; jj < 4; ++jj) el[jj] = (c == g) ? le[4 * c + jj] : el[jj];
            int i1 = 0; float v1 = el[0];
#pragma unroll
            for (int jj = 1; jj < 4; ++jj) if (el[jj] > v1) { v1 = el[jj]; i1 = jj; }
            int i2 = (i1 == 0) ? 1 : 0; float v2 = el[i2];
#pragma unroll
            for (int jj = 0; jj < 4; ++jj) if (jj != i1 && el[jj] > v2) { v2 = el[jj]; i2 = jj; }
            const float e2 = __expf(v2 - v1); const float w1 = pg / (1.f + e2), w2 = pg * e2 / (1.f + e2);
            const int lo = i1 < i2 ? i1 : i2, hi = i1 < i2 ? i2 : i1; const float wlo = i1 < i2 ? w1 : w2, whi = i1 < i2 ? w2 : w1;
            const int pi = lo == 0 ? hi - 1 : (lo == 1 ? hi + 1 : 5);
            const int bucket = g * 6 + pi;
            int rank = 0, nsame = 1, leader = C.tid;
#pragma unroll 1
            for (int b = 0; b < NBUCKET; ++b) { const unsigned long long m = __builtin_amdgcn_ballot_w64(bucket == b);
                if (bucket == b) { rank = (int)__builtin_amdgcn_mbcnt_hi((unsigned)(m >> 32), __builtin_amdgcn_mbcnt_lo((unsigned)m, 0u)); nsame = __builtin_popcountll(m); leader = __builtin_ctzll(m); } }
            unsigned base = 0u; if (rank == 0) base = __hip_atomic_fetch_add(cnt + bucket, (unsigned)nsame, RLX_AGENT);
            base = (unsigned)__builtin_amdgcn_ds_bpermute(leader << 2, (int)base);
            const unsigned pos = base + (unsigned)rank; const size_t slot = (size_t)bucket * T + pos;
            perm2[slot] = t; *(GAS f32x4*)(roww2 + 4 * slot) = (f32x4){wlo, whi, rstd, 0.f};
        }
    }
}
__device__ __forceinline__ void moe_tables(Ctx& C, int layer) {
    GAS unsigned* cnt = (GAS unsigned*)C.ctl + CW_CNT + layer * 32;
    __syncthreads();
    if (C.tid < NBUCKET) C.lw[LW_CNT + C.tid] = __hip_atomic_load(cnt + C.tid, RLX_AGENT);
    __syncthreads();
    if (C.tid == 0) { unsigned acc = 0; for (int b = 0; b < NBUCKET; ++b) { C.lw[LW_TSTART + b] = acc; acc += (C.lw[LW_CNT + b] + 255u) >> 8; } C.lw[LW_TSTART + NBUCKET] = acc; C.lw[LW_NT] = acc; }
    __syncthreads();
}
constexpr int PH_PER_LAYER = 9, N_PHASES = NLAYER * PH_PER_LAYER;
template <int PMASK> __global__ void __launch_bounds__(NTHR, 2) fwd(Args args) {
    extern __shared__ __attribute__((aligned(16))) unsigned char lds_raw[];
    const CAS Args* ap = (const CAS Args*)__builtin_amdgcn_kernarg_segment_ptr();
    Ctx C;
    C.lds = (LAS unsigned char*)lds_raw; C.lw = (volatile LAS unsigned*)(C.lds + LDS_CTL_OFF);
    C.out = (GAS float*)args.out; C.ws = (GAS unsigned char*)args.ws; C.ctl = (gu32*)(args.ws + WS_CTL);
    C.tid = threadIdx.x; C.lane = C.tid & 63; C.wave = __builtin_amdgcn_readfirstlane(C.tid >> 6);
    C.G = gridDim.x; C.bid = blockIdx.x; { const int bx = blockIdx.x; C.vcu = (C.G % 8 == 0) ? (bx % 8) * (C.G / 8) + bx / 8 : bx; }
    C.zf = 0.f;
    for (int u = C.tid; u < (LDS_BYTES - LDS_CTL_OFF) / 4; u += NTHR) C.lw[u] = 0u;
    __syncthreads();
#if MEGA
    XcdBarrier bar = xcd_barrier_post((unsigned*)(args.ws + WS_CTL) + CW_BAR, C.lw + LW_BAR);
#define GRID_BAR() do { XcdBarrier b2_ = bar; asm volatile("" : "+s"(b2_.bar)); xcd_barrier(b2_); } while (0)
#else
#define GRID_BAR() do {} while (0)
#endif
    const int lo = args.ph_lo, hi = args.ph_hi;
#define IN(k) (((PMASK >> ((k) % PH_PER_LAYER)) & 1) && lo <= (k) && (k) < hi)
#define SEAM(k) do { if (IN(k) && IN((k) + 1)) GRID_BAR(); relaunder(C); asm volatile("" : "+s"(ap)); } while (0)
    for (int layer = 0; layer < NLAYER; ++layer) {
        const int p0 = layer * PH_PER_LAYER;
        if (IN(p0 + 0)) { for (int rep = 0; rep < NREP(0); ++rep) phase_prep(C, ap, layer, false, C.vcu * NWAVES + C.wave, C.G * NWAVES); } SEAM(p0 + 0);
        if (IN(p0 + 1)) { const GAS char* ws = (const GAS char*)C.ws;
            SchedInProj S{ws + WS_H, ws + WS_WIN, ws + WS_MEMH, ws + WS_WMKV, C.G, C.bid, 0};
            EpiInProj E{(GAS bf16*)(C.ws + WS_P1), (GAS bf16*)(C.ws + WS_P2), (GAS bf16*)(C.ws + WS_P3), (GAS bf16*)(C.ws + WS_P4), (GAS bf16*)(C.ws + WS_KVM)};
            for (int rep = 0; rep < NREP(1); ++rep) gemm_run<1, EpiInProj, SchedInProj, 1>(C.lds, D * 2, D * 2, D / 64, S, E);
            __syncthreads();
            {
                EpiGate EG{(GAS unsigned char*)(C.ws + WS_P4), (GAS bf16*)(C.ws + WS_P2), (GAS bf16*)(C.ws + WS_P3)};
                const int rem1 = (64 * 8 + 4 * 8) % C.G;
                { SchedGate SG{ws + WS_H8, ws + WS_WG8, C.G, C.bid, rem1, 0, 1 << 20}; pg8::gemm_fast<EpiGate, SchedGate, 1, true>(C.lds, D, D, D / 128, SG, EG); }
            }
        } SEAM(p0 + 1);
        if (IN(p0 + 2)) { for (int rep = 0; rep < NREP(2); ++rep) phase_mix(C, ap, layer, LATE_PCT == 2 ? (C.bid % 3) : -1); } SEAM(p0 + 2);
        if (IN(p0 + 3)) { const GAS char* ws = (const GAS char*)C.ws;
            for (int rep = 0; rep < NREP(3); ++rep) {
                { SchedMerge S{ws + WS_Y, ws + WS_WBR, C.G, C.bid};
                  EpiMerge E{(const GAS unsigned char*)(C.ws + WS_P4), (GAS bf16*)(C.ws + WS_MF), (GAS bf16*)(C.ws + WS_H), 1.f / 255.f, layer == NLAYER - 1 ? 1 : 0};
                  gemm_run<3, EpiMerge, SchedMerge, 1>(C.lds, 6144, 1024 * 2, 1024 / 64, S, E); }
                __syncthreads();
                { SchedMerge8 S{ws + WS_Y, ws + WS_WBR, C.G, C.bid};
                  EpiMerge E{(const GAS unsigned char*)(C.ws + WS_P4), (GAS bf16*)(C.ws + WS_MF), (GAS bf16*)(C.ws + WS_H), 1.f / (255.f * YBC8_SCALE * WBR8_SCALE), layer == NLAYER - 1 ? 1 : 0};
                  pg8::gemm_fast<EpiMerge, SchedMerge8, 1, true>(C.lds, 6144, 1024, 1024 / 128, S, E); }
            }
        } SEAM(p0 + 3);
        if (IN(p0 + 4)) { const GAS char* ws = (const GAS char*)C.ws;
            if (layer == NLAYER - 1) {
                SchedOut S{ws + WS_H8, ws + WS_WOUT, C.G, C.bid, 1};
                EpiOut E{(const GAS float*)ap->in[0], (GAS bf16*)(C.ws + WS_XB), layer == 0 ? 1 : 0, 1.f / (MRG8_SCALE * WOUT8_SCALE)};
                pg8::gemm_fast<EpiOut, SchedOut, 1, true>(C.lds, D, D, D / 128, S, E);
            } else {
                SchedOut S{ws + WS_H, ws + WS_WOUT, C.G, C.bid, 2};
                EpiOut E{(const GAS float*)ap->in[0], (GAS bf16*)(C.ws + WS_XB), layer == 0 ? 1 : 0, 1.f};
                gemm_run<4, EpiOut, SchedOut, 1>(C.lds, D * 2, D * 2, D / 64, S, E);
            }
        } SEAM(p0 + 4);
        if (IN(p0 + 5)) { phase_route(C, ap, layer); } SEAM(p0 + 5);
        if (IN(p0 + 7)) { const GAS char* ws = (const GAS char*)C.ws;
            moe_tables(C, layer);
            SchedMoe1 S{ws + (MOE1_FP8 ? WS_H8 : WS_H), ws + WS_WGU, (const GAS int*)(C.ws + WS_PERM2), C.lw, C.G, C.vcu};
            EpiMoe1 E{(const GAS float*)(C.ws + WS_ROWW2), (GAS bf16*)(C.ws + WS_HID)};
            for (int rep = 0; rep < NREP(7); ++rep) { if constexpr (MOE1_FP8) pg8::gemm_fast<EpiMoe1, SchedMoe1, 1, true>(C.lds, D, D, D / 128, S, E); else pg8::gemm_fast<EpiMoe1, SchedMoe1, 1, false>(C.lds, D * 2, D * 2, D / 64, S, E); }
        } SEAM(p0 + 7);
        if (IN(p0 + 8)) { const GAS char* ws = (const GAS char*)C.ws;
            moe_tables(C, layer);
            SchedMoe2 S{ws + WS_HID, ws + WS_WD, C.lw, C.G, C.vcu};
            EpiMoe2 E{(const GAS int*)(C.ws + WS_PERM2), (GAS bf16*)(C.ws + WS_XB), C.out, layer == NLAYER - 1 ? 1 : 0};
            if constexpr (MOE2_FP8) pg8::gemm_fast<EpiMoe2, SchedMoe2, 2, true>(C.lds, 1024, DFF, DFF / 128, S, E);
            else pg8::gemm_fast<EpiMoe2, SchedMoe2, 2, false>(C.lds, 1024 * 2, DFF * 2, DFF / 64, S, E);
        } SEAM(p0 + 8);
    }
#undef IN
#undef SEAM
}

#ifdef TESTMASK
template __global__ void fwd<TESTMASK>(Args);
#else
extern "C" void kernel_launch(void* const* d_in, const int* in_sizes, int n_in, void* d_out, int out_size, void* d_ws, size_t ws_size, hipStream_t stream) {
    static int grid = 0;
    if (grid == 0) {
        if (n_in != 24 || in_sizes[0] != T * D || out_size != T * D || ws_size < WS_END) { fprintf(stderr, "kernel_launch: unexpected shapes / workspace (n_in %d, ws %zu < %zu)\n", n_in, ws_size, (size_t)WS_END); grid = -1; return; }
        int dev = 0, cus = 0, per_cu = 0;
        if (hipGetDevice(&dev) != hipSuccess || hipDeviceGetAttribute(&cus, hipDeviceAttributeMultiprocessorCount, dev) != hipSuccess) { grid = -1; return; }
#if MEGA
        const void* fns[1] = {(const void*)fwd<0x1FF>};
#else
        const void* fns[9] = {(const void*)fwd<1>, (const void*)fwd<2>, (const void*)fwd<4>, (const void*)fwd<8>, (const void*)fwd<16>, (const void*)fwd<32>, (const void*)fwd<64>, (const void*)fwd<128>, (const void*)fwd<256>};
#endif
        for (const void* fn : fns) {
            if (hipFuncSetAttribute(fn, hipFuncAttributeMaxDynamicSharedMemorySize, LDS_BYTES) != hipSuccess) { fprintf(stderr, "kernel_launch: hipFuncSetAttribute failed\n"); grid = -1; return; }
            if (hipOccupancyMaxActiveBlocksPerMultiprocessor(&per_cu, fn, NTHR, LDS_BYTES) != hipSuccess || per_cu < 1) fprintf(stderr, "kernel_launch: occupancy query reports %d\n", per_cu);
        }
        (void)hipGetLastError();
        grid = cus;
    }
    if (grid < 0) return;
    if (hipMemsetAsync((char*)d_ws + WS_CTL, 0, CTL_ZERO_BYTES, stream) != hipSuccess) return;
    Args a{};
    for (int i = 0; i < 24; ++i) a.in[i] = (const float*)d_in[i];
    a.out = (float*)d_out; a.ws = (unsigned char*)d_ws;
#if MEGA
    a.ph_lo = 0; a.ph_hi = N_PHASES;
    hipLaunchKernelGGL(fwd<0x1FF>, dim3(grid), dim3(NTHR), LDS_BYTES, stream, a);
#else
    for (int p = 0; p < N_PHASES; ++p) {
        a.ph_lo = p; a.ph_hi = p + 1; const int k = p % PH_PER_LAYER;
        switch (k) {
        case 0: hipLaunchKernelGGL(fwd<1>, dim3(grid), dim3(NTHR), LDS_BYTES, stream, a); break;
        case 1: hipLaunchKernelGGL(fwd<2>, dim3(grid), dim3(NTHR), LDS_BYTES, stream, a); break;
        case 2: hipLaunchKernelGGL(fwd<4>, dim3(grid), dim3(NTHR), LDS_BYTES, stream, a); break;
        case 3: hipLaunchKernelGGL(fwd<8>, dim3(grid), dim3(NTHR), LDS_BYTES, stream, a); break;
        case 4: hipLaunchKernelGGL(fwd<16>, dim3(grid), dim3(NTHR), LDS_BYTES, stream, a); break;
        case 5: hipLaunchKernelGGL(fwd<32>, dim3(grid), dim3(NTHR), LDS_BYTES, stream, a); break;
        case 6: hipLaunchKernelGGL(fwd<64>, dim3(grid), dim3(NTHR), LDS_BYTES, stream, a); break;
        case 7: hipLaunchKernelGGL(fwd<128>, dim3(grid), dim3(NTHR), LDS_BYTES, stream, a); break;
        default: hipLaunchKernelGGL(fwd<256>, dim3(grid), dim3(NTHR), LDS_BYTES, stream, a); break;
        }
    }
#endif
}
#endif
```

```cpp
#include <hip/hip_runtime.h>
#include <cstdio>
#include <cstdint>
#include <type_traits>

#ifndef MEGA
#define MEGA 1
#endif
#ifndef FAST_GEMM
#define FAST_GEMM 0
#endif

#define GAS __attribute__((address_space(1)))
#define CAS __attribute__((address_space(4)))
#define LAS __attribute__((address_space(3)))
typedef unsigned short bf16;
typedef unsigned v4u __attribute__((ext_vector_type(4)));
typedef unsigned v2u __attribute__((ext_vector_type(2)));
typedef float f32x4 __attribute__((ext_vector_type(4)));
typedef float f32x2 __attribute__((ext_vector_type(2)));
typedef short bf16x8 __attribute__((ext_vector_type(8)));
typedef GAS unsigned gu32;
#define RLX_AGENT __ATOMIC_RELAXED, __HIP_MEMORY_SCOPE_AGENT
#define LDS_WAIT() asm volatile("s_waitcnt lgkmcnt(0)" ::: "memory")
#define VM_WAIT() asm volatile("s_waitcnt vmcnt(0)" ::: "memory")

constexpr int NB = 4, SEQ = 4096, T = NB * SEQ, D = 2048, NIN = 10752, MEML = 256, MEMT = NB * MEML, NLAYER = 2;
constexpr int NEXP = 16, DFF = 512;
constexpr int NBUCKET = 24;
constexpr int TPAD = T + NBUCKET * 256;
constexpr float EPS = 1e-6f;
constexpr int NWAVES = 8, NTHR = 512;

constexpr size_t MiB = 1u << 20;
constexpr size_t WS_CTL = 0, CTL_ZERO_BYTES = 1 * MiB;
constexpr size_t WS_WIN = 4 * MiB;
constexpr size_t WS_WMKV = 46 * MiB;
constexpr size_t WS_WBR = 54 * MiB;
constexpr size_t WS_WOUT = 66 * MiB;
constexpr size_t WS_WGU = 74 * MiB;
constexpr size_t WS_WD = 138 * MiB;
constexpr size_t WS_H = 170 * MiB;
constexpr size_t WS_MEMH = 234 * MiB;
constexpr size_t WS_KVM = 238 * MiB;
constexpr size_t WS_P1 = 242 * MiB;
constexpr size_t WS_P2 = 306 * MiB;
constexpr size_t WS_P3 = 354 * MiB;
constexpr size_t WS_P4 = 386 * MiB;
constexpr size_t WS_XB = 482 * MiB;
constexpr size_t WS_Y = 578 * MiB;
constexpr size_t WS_H8 = 674 * MiB;
constexpr size_t WS_WG8 = 12 * MiB;
constexpr size_t WS_PERM2 = 706 * MiB;
constexpr size_t WS_ROWW2 = 708 * MiB;
constexpr size_t WS_END = 718 * MiB;
constexpr size_t WS_MF = WS_P1;
constexpr size_t WS_HID = WS_Y;
static_assert(WS_MF + (size_t)T * D * 2 <= WS_P2 && WS_HID + (size_t)TPAD * 1024 * 2 <= WS_H8, "overlays");
static_assert(WS_P4 + (size_t)T * 6144 <= WS_XB && WS_XB + (size_t)T * D * 2 <= WS_Y, "residual stream region");
static_assert(WS_PERM2 + (size_t)NBUCKET * T * 4 <= WS_ROWW2 && WS_ROWW2 + (size_t)NBUCKET * T * 16 <= WS_END, "bucket tables");
constexpr int CW_BAR = 4096;
constexpr int CW_CNT = 16384;

constexpr int LDS_BYTES = 147456;
constexpr int LDS_CTL_OFF = 146432;
constexpr int LW_BAR = 0;
constexpr int LW_TSTART = 16;
constexpr int LW_CNT = 48;
constexpr int LW_NT = 80;

__device__ __forceinline__ unsigned f2bf(float f) { unsigned u = __builtin_bit_cast(unsigned, f); return (u + 0x7fffu + ((u >> 16) & 1u)) >> 16; }
__device__ __forceinline__ unsigned pk2(float lo, float hi) { return f2bf(lo) | (f2bf(hi) << 16); }
__device__ __forceinline__ float bf2f(unsigned short b) { return __builtin_bit_cast(float, (unsigned)b << 16); }
__device__ __forceinline__ float bflo(unsigned w) { return __builtin_bit_cast(float, w << 16); }
__device__ __forceinline__ float bfhi(unsigned w) { return __builtin_bit_cast(float, w & 0xffff0000u); }
typedef __bf16 bf16x2_t __attribute__((ext_vector_type(2)));
__device__ __forceinline__ unsigned cvt_pk_bf16(float lo, float hi) { f32x2 v = {lo, hi}; bf16x2_t b = __builtin_convertvector(v, bf16x2_t); return __builtin_bit_cast(unsigned, b); }
__device__ __forceinline__ float shx(float v, int o, int lane) { return __builtin_bit_cast(float, __builtin_amdgcn_ds_bpermute((lane ^ o) << 2, __builtin_bit_cast(int, v))); }
__device__ __forceinline__ float wave_sum(float v, int lane) {
    (void)lane; int x;
    x = __builtin_amdgcn_update_dpp(0, __builtin_bit_cast(int, v), 0xB1, 0xf, 0xf, true); v += __builtin_bit_cast(float, x);
    x = __builtin_amdgcn_update_dpp(0, __builtin_bit_cast(int, v), 0x4E, 0xf, 0xf, true); v += __builtin_bit_cast(float, x);
    x = __builtin_amdgcn_update_dpp(0, __builtin_bit_cast(int, v), 0x141, 0xf, 0xf, true); v += __builtin_bit_cast(float, x);
    x = __builtin_amdgcn_update_dpp(0, __builtin_bit_cast(int, v), 0x140, 0xf, 0xf, true); v += __builtin_bit_cast(float, x);
    x = __builtin_amdgcn_update_dpp(0, __builtin_bit_cast(int, v), 0x142, 0xa, 0xf, false); v += __builtin_bit_cast(float, x);
    x = __builtin_amdgcn_update_dpp(0, __builtin_bit_cast(int, v), 0x143, 0xc, 0xf, false); v += __builtin_bit_cast(float, x);
    return __builtin_bit_cast(float, __builtin_amdgcn_readlane(__builtin_bit_cast(int, v), 63));
}
__device__ __forceinline__ float sigmoidf_(float x) { return __builtin_amdgcn_rcpf(1.f + __builtin_amdgcn_exp2f(-1.4426950408889634f * x)); }
__device__ __forceinline__ f32x2 gelu_pk(f32x2 v) {
    const f32x2 av = __builtin_elementwise_abs(v), d = av * 0.2316418882f + 1.0f;
    f32x2 t; t.x = __builtin_amdgcn_rcpf(d.x); t.y = __builtin_amdgcn_rcpf(d.y);
    f32x2 q = t * 0.5307027145f + (-0.7265760135f); q = q * t + 0.7107068705f; q = q * t + (-0.142248368f); q = q * t + 0.127414796f; q = q * t;
    const f32x2 s = (v * v) * (-0.72134752044f);
    f32x2 e; e.x = __builtin_amdgcn_exp2f(s.x); e.y = __builtin_amdgcn_exp2f(s.y);
    const f32x2 m = v * (q * e), r = v - m;
    f32x2 o; o.x = v.x < 0.f ? m.x : r.x; o.y = v.y < 0.f ? m.y : r.y; return o;
}
__device__ __forceinline__ f32x4 gelu4(f32x4 v) { f32x2 a = gelu_pk((f32x2){v[0], v[1]}), b = gelu_pk((f32x2){v[2], v[3]}); return (f32x4){a.x, a.y, b.x, b.y}; }
__device__ __forceinline__ f32x4 sigm4(f32x4 v) { return (f32x4){sigmoidf_(v[0]), sigmoidf_(v[1]), sigmoidf_(v[2]), sigmoidf_(v[3])}; }
__device__ __forceinline__ v4u pack8(f32x4 a, f32x4 b) { v4u w; w.x = cvt_pk_bf16(a[0], a[1]); w.y = cvt_pk_bf16(a[2], a[3]); w.z = cvt_pk_bf16(b[0], b[1]); w.w = cvt_pk_bf16(b[2], b[3]); return w; }

__device__ __forceinline__ float sat8(float x) { return __builtin_amdgcn_fmed3f(x, -448.f, 448.f); }
__device__ __forceinline__ unsigned pk4_fp8(float a, float b, float c, float d) { int r = __builtin_amdgcn_cvt_pk_fp8_f32(sat8(a), sat8(b), 0, false); r = __builtin_amdgcn_cvt_pk_fp8_f32(sat8(c), sat8(d), r, true); return (unsigned)r; }
#ifndef MOE2_FP8
#define MOE2_FP8 1
#endif
#ifndef MOE1_FP8
#define MOE1_FP8 1
#endif
constexpr float WGU8_SCALE = MOE1_FP8 ? 32.f : 1.f, WD8_SCALE = MOE2_FP8 ? 16.f : 1.f, HID8_SCALE = MOE2_FP8 ? 8.f : 1.f;
constexpr float YBC8_SCALE = 16.f, WBR8_SCALE = 32.f;
constexpr float MRG8_SCALE = 16.f, WOUT8_SCALE = 32.f;
constexpr float WG8_SCALE = 32.f;
#define XB_TMO      128
#define XB_XCNT(j)  (256  + 64 * (j))
#define XB_XSUB(j)  (1280 + 64 * (j))
#define XB_XGEN(j)  (2304 + 64 * (j))
#define XB_TOP      3328
#define XB_TOPGEN   3392
#define XCD_BAR_WORDS 3456
#define XB_SPIN_CAP (1u << 18)
__device__ __forceinline__ unsigned xb_ld(unsigned* p)              { return __hip_atomic_load(p, __ATOMIC_RELAXED, __HIP_MEMORY_SCOPE_AGENT); }
__device__ __forceinline__ unsigned xb_add(unsigned* p, unsigned v) { return __hip_atomic_fetch_add(p, v, __ATOMIC_RELAXED, __HIP_MEMORY_SCOPE_AGENT); }
__device__ __forceinline__ unsigned xb_xcc_id() { return (unsigned)__builtin_amdgcn_s_getreg((3 << 11) | 20) & 0xFu; }
#define XB_SPIN(cond, bar) do { unsigned _sp = 0; while (cond) { __builtin_amdgcn_s_sleep(1); \
    if ((++_sp & 255u) == 0u) { if (xb_ld(&(bar)[XB_TMO])) break; if (_sp > XB_SPIN_CAP) { atomicAdd(&(bar)[XB_TMO], 1u); break; } } } } while (0)
struct XcdBarrier { unsigned* bar; unsigned x; volatile LAS unsigned* st; };
__device__ __forceinline__ XcdBarrier xcd_barrier_post(unsigned* bar, volatile LAS unsigned* st) {
    XcdBarrier b; b.bar = bar; b.x = xb_xcc_id(); b.st = st;
    if (threadIdx.x == 0) (void)xb_add(&bar[XB_XCNT(b.x)], 1u);
    return b;
}
__device__ __forceinline__ void xcd_barrier_complete(unsigned* bar, unsigned x, unsigned& nloc, unsigned& nx) {
    const unsigned G = gridDim.x * gridDim.y * gridDim.z;
    unsigned sum, cnt, mine, sp = 0u;
    for (;;) {
        sum = 0u; cnt = 0u; mine = 0u;
#pragma unroll 1
        for (unsigned j = 0; j < 16; ++j) { const unsigned c = xb_ld(&bar[XB_XCNT(j)]); sum += c; cnt += (c > 0u) ? 1u : 0u; mine = (j == x) ? c : mine; }
        if (sum == G) break;
        __builtin_amdgcn_s_sleep(1);
        if ((++sp & 255u) == 0u) { if (xb_ld(&bar[XB_TMO])) break; if (sp > XB_SPIN_CAP) { atomicAdd(&bar[XB_TMO], 1u); break; } }
    }
    nloc = mine > 0u ? mine : 1u; nx = cnt > 0u ? cnt : 1u;
}
__device__ __forceinline__ void xcd_barrier(const XcdBarrier& b) {
    asm volatile("s_waitcnt vmcnt(0)" ::: "memory");
    __syncthreads();
    if (threadIdx.x == 0) {
        unsigned* bar = b.bar;
        __builtin_amdgcn_s_waitcnt(0);
        unsigned nloc = b.st[0], nx = b.st[1];
        if (nloc == 0u) { xcd_barrier_complete(bar, b.x, nloc, nx); b.st[0] = nloc; b.st[1] = nx; }
        const unsigned old = xb_add(&bar[XB_XSUB(b.x)], 1u);
        const unsigned gen = old / nloc;
        if (old + 1u == (gen + 1u) * nloc) {
            __builtin_amdgcn_fence(__ATOMIC_RELEASE, "agent");
            asm volatile("s_waitcnt vmcnt(0)" ::: "memory");
            const unsigned og = xb_add(&bar[XB_TOP], 1u);
            const unsigned tg = og / nx;
            if (og + 1u == (tg + 1u) * nx) xb_add(&bar[XB_TOPGEN], 1u);
            else XB_SPIN(xb_ld(&bar[XB_TOPGEN]) == tg, bar);
            __builtin_amdgcn_fence(__ATOMIC_ACQUIRE, "agent");
            xb_add(&bar[XB_XGEN(b.x)], 1u);
            asm volatile("s_waitcnt vmcnt(0)" ::: "memory");
        } else {
            XB_SPIN(xb_ld(&bar[XB_XGEN(b.x)]) == gen, bar);
            __builtin_amdgcn_fence(__ATOMIC_ACQUIRE, "agent");
            asm volatile("s_waitcnt vmcnt(0)" ::: "memory");
        }
    }
    __syncthreads();
}

struct Unit { const GAS char* A; const GAS char* B; const GAS char* A2; const GAS char* B2; int pm, pn, aux, nv; };

constexpr int NXCD = 8, WGM = 8;
__device__ __forceinline__ void tile_order(int L, int nM, int nN, int& pm, int& pn) {
    const int nwg = nM * nN;
    int wgid = L; { const int q = nwg / NXCD, r = nwg % NXCD, xcd = wgid % NXCD, off = wgid / NXCD; wgid = (xcd < r ? xcd * (q + 1) : r * (q + 1) + (xcd - r) * q) + off; }
    const int nig = WGM * nN, gid = wgid / nig, fm = gid * WGM, gsz = (nM - fm) < WGM ? (nM - fm) : WGM;
    pm = fm + ((wgid % nig) % gsz); pn = (wgid % nig) / gsz;
}

struct SchedInProj {
    static constexpr bool GATHER = false;
    const GAS char* H; const GAS char* Win; const GAS char* MemH; const GAS char* Wmkv; int G, c, mode;
    __device__ __forceinline__ bool next(int i, Unit& u) const {
        int L = i * G + c; constexpr int N1 = 64 * 8, N2 = 4 * 8;
        if (mode == 2) L += N1;
        if (L >= (mode == 1 ? N1 : N1 + N2)) return false;
        if (L < N1) { int pm, pn; tile_order(L, 64, 8, pm, pn); u.pm = pm; u.pn = pn; u.aux = 0; u.A = H + (size_t)pm * 256 * D * 2; u.B = Win + (size_t)pn * 256 * D * 2; }
        else { const int r = L - N1; u.pm = r & 3; u.pn = r >> 2; u.aux = 1; u.A = MemH + (size_t)u.pm * 256 * D * 2; u.B = Wmkv + (size_t)u.pn * 256 * D * 2; }
        u.A2 = u.A; u.B2 = u.B; return true;
    }
};
struct SchedGate {
    static constexpr bool GATHER = false;
    const GAS char* H8; const GAS char* Wg8; int G, c, rem, ibeg, iend;
    __device__ __forceinline__ bool next(int i0, Unit& u) const {
        constexpr int NF = 64 * 34; int L; const int i = i0 + ibeg; if (i >= iend) return false;
        const int nh = (NF + 3 * rem + G - 1) / G;
        if (rem == 0 || nh < 3) { L = i * G + c; if (L >= NF) return false; }
        else { const int Gh = G - rem; const int nhT = nh * Gh < NF ? nh * Gh : NF;
            if (c >= rem) { L = i * Gh + (c - rem); if (i >= nh || L >= nhT) return false; }
            else { L = nhT + i * rem + c; if (L >= NF) return false; } }
        int pm, pn; tile_order(L, 64, 34, pm, pn); u.pm = pm; u.pn = pn; u.aux = 0;
        u.A = H8 + (size_t)pm * 256 * D; u.B = Wg8 + (size_t)pn * 256 * D; u.A2 = u.A; u.B2 = u.B; return true;
    }
};
struct SchedMerge {
    static constexpr bool GATHER = false;
    const GAS char* Y; const GAS char* Wbr; int G, c;
    __device__ __forceinline__ bool next(int i, Unit& u) const {
        const int L = i * G + c;
        if (L >= 64 * 8) return false;
        int pm, pn; tile_order(L, 64, 8, pm, pn); u.pm = pm; u.pn = pn; u.aux = 0;
        u.A = Y + (size_t)pm * 256 * 6144; u.B = Wbr + (size_t)pn * 256 * 1024 * 2; u.A2 = u.A; u.B2 = u.B; return true;
    }
};
struct SchedMerge8 {
    static constexpr bool GATHER = false;
    const GAS char* Y; const GAS char* Wbr; int G, c;
    __device__ __forceinline__ bool next(int i, Unit& u) const {
        const int j = i >> 1, n = 1 + (i & 1); const int L = j * G + c;
        if (L >= 64 * 8) return false;
        int pm, pn; tile_order(L, 64, 8, pm, pn); u.pm = pm; u.pn = pn; u.aux = n;
        u.A = Y + (size_t)pm * 256 * 6144 + 1024 + (size_t)n * 1024; u.B = Wbr + (size_t)(n + 1) * 2048 * 1024 + (size_t)pn * 256 * 1024; u.A2 = u.A; u.B2 = u.B; return true;
    }
};
struct SchedOut {
    static constexpr bool GATHER = false;
    const GAS char* Mg; const GAS char* Wout; int G, c, esz;
    __device__ __forceinline__ bool next(int i, Unit& u) const {
        const int L = i * G + c; if (L >= 64 * 8) return false;
        int pm, pn; tile_order(L, 64, 8, pm, pn); u.pm = pm; u.pn = pn; u.aux = 0;
        u.A = Mg + (size_t)pm * 256 * D * esz; u.B = Wout + (size_t)pn * 256 * D * esz; u.A2 = u.A; u.B2 = u.B; return true;
    }
};
__device__ __forceinline__ int bucket_of_tile(const volatile LAS unsigned* lw, int rt) {
    int b = 0;
#pragma unroll 1
    for (int k = 1; k < NBUCKET; ++k) b = ((int)lw[LW_TSTART + k] <= rt) ? k : b;
    return b;
}
__device__ __forceinline__ void bucket_experts(int b, int& elo, int& ehi) { const int g = b / 6, pi = b - 6 * g; elo = 4 * g + ((2368 >> (2 * pi)) & 3); ehi = 4 * g + ((4025 >> (2 * pi)) & 3); }
struct SchedMoe1 {
    static constexpr bool GATHER = true;
    const GAS char* Hb; const GAS char* Wgu; const GAS int* perm; const volatile LAS unsigned* lw; int G, vcu;
    __device__ __forceinline__ bool next(int i, Unit& u) const {
        const int L = i * G + vcu, rt = L >> 3, pn = L & 7; const int ntile = (int)lw[LW_NT];
        if (rt >= ntile) return false;
        const int b = bucket_of_tile(lw, rt); int elo, ehi; bucket_experts(b, elo, ehi);
        const int e = __builtin_amdgcn_readfirstlane(pn < 4 ? elo : ehi); const int lt = rt - (int)lw[LW_TSTART + b];
        u.pm = rt; u.pn = pn; u.aux = __builtin_amdgcn_readfirstlane(b * T + lt * 256); u.nv = __builtin_amdgcn_readfirstlane((int)lw[LW_CNT + b] - lt * 256);
        u.A = Hb; u.B = Wgu + ((size_t)e * 1024 + (size_t)(pn & 3) * 256) * D * (MOE1_FP8 ? 1 : 2); u.A2 = u.A; u.B2 = u.B; return true;
    }
    __device__ __forceinline__ void aoffs(const Unit& u, const int (&R)[2], const int (&Cc)[2], unsigned (&o)[2][2]) const {
#pragma unroll
        for (int h = 0; h < 2; ++h)
#pragma unroll
            for (int i = 0; i < 2; ++i) { const int rr = 128 * h + R[i]; int tok = perm[u.aux + (rr < u.nv ? rr : 0)]; tok = rr < u.nv ? tok : 0; o[h][i] = (unsigned)tok * (unsigned)(D * (MOE1_FP8 ? 1 : 2)) + (unsigned)(Cc[i] * 2); }
    }
};
struct SchedMoe2 {
    static constexpr bool GATHER = false;
    const GAS char* HID; const GAS char* Wd; const volatile LAS unsigned* lw; int G, vcu;
    __device__ __forceinline__ bool next(int i, Unit& u) const {
        const int L = i * G + vcu, rt = L >> 3, pn = L & 7; const int ntile = (int)lw[LW_NT];
        if (rt >= ntile) return false;
        const int b = bucket_of_tile(lw, rt); int elo, ehi; bucket_experts(b, elo, ehi);
        elo = __builtin_amdgcn_readfirstlane(elo); ehi = __builtin_amdgcn_readfirstlane(ehi); const int lt = rt - (int)lw[LW_TSTART + b];
        u.pm = rt; u.pn = pn; u.aux = __builtin_amdgcn_readfirstlane(b * T + lt * 256); u.nv = __builtin_amdgcn_readfirstlane((int)lw[LW_CNT + b] - lt * 256);
        constexpr int ES = MOE2_FP8 ? 1 : 2;
        u.A = HID + (size_t)rt * 256 * 1024 * ES; u.A2 = u.A + 512 * ES;
        u.B = Wd + ((size_t)elo * D + (size_t)pn * 256) * DFF * ES; u.B2 = Wd + ((size_t)ehi * D + (size_t)pn * 256) * DFF * ES; return true;
    }
};

struct EpiInProj {
    static constexpr bool PAIR = false, HASPRE = false, HASROW = false, WIDE8 = false;
    GAS bf16 *P1, *P2, *P3, *P4, *KVM;
    __device__ __forceinline__ void tile8(const Unit& u, int r, int c, f32x4 v0, f32x4 v1) const {
        const size_t row = (size_t)u.pm * 256 + r; const int pn = u.pn;
        if (u.aux) { *(GAS v4u*)(KVM + row * 2048 + pn * 256 + c) = pack8(v0, v1); return; }
        *(GAS v4u*)(P1 + row * 2048 + pn * 256 + c) = pack8(gelu4(v0), gelu4(v1));
    }
};
struct EpiNull { static constexpr bool PAIR = false, HASPRE = false, HASROW = false, WIDE8 = false; GAS float* sink;
    __device__ __forceinline__ void tile8(const Unit& u, int r, int c, f32x4 v0, f32x4 v1) const { if (v0[0] == 1.2345e30f && v1[3] == -7.7e29f) sink[r] = 1.f; } };
struct EpiGate {
    static constexpr bool PAIR = false, HASPRE = false, HASROW = false;
    GAS unsigned char* P4; GAS bf16* P2; GAS bf16* P3;
    __device__ __forceinline__ void tile8(const Unit& u, int r, int c, f32x4 v0, f32x4 v1) const {
        const size_t row = (size_t)u.pm * 256 + r; const float sc = 1.f / WG8_SCALE;
        if (u.pn < 6) { *(GAS v4u*)(P2 + row * 1536 + u.pn * 256 + c) = pack8(v0 * sc, v1 * sc); return; }
        if (u.pn < 10) { *(GAS v4u*)(P3 + row * 1024 + (u.pn - 6) * 256 + c) = pack8(v0 * sc, v1 * sc); return; }
        *(GAS v2u*)(P4 + row * 6144 + (u.pn - 10) * 256 + c) = pack8u(v0, v1);
    }
    static constexpr bool WIDE8 = true;
    __device__ __forceinline__ bool wide(const Unit& u) const { return u.pn >= 10; }
    __device__ __forceinline__ v2u pack8u(f32x4 v0, f32x4 v1) const { const float sc = 1.f / WG8_SCALE;
        const f32x4 a = sigm4(v0 * sc) * 255.f + 0.5f, b = sigm4(v1 * sc) * 255.f + 0.5f;
        v2u o; o.x = (unsigned)a[0] | ((unsigned)a[1] << 8) | ((unsigned)a[2] << 16) | ((unsigned)a[3] << 24); o.y = (unsigned)b[0] | ((unsigned)b[1] << 8) | ((unsigned)b[2] << 16) | ((unsigned)b[3] << 24); return o; }
    __device__ __forceinline__ void store16(const Unit& u, int r, int c, v4u o) const { *(GAS v4u*)(P4 + ((size_t)u.pm * 256 + r) * 6144 + (u.pn - 10) * 256 + c) = o; }
};
struct EpiMerge {
    static constexpr bool PAIR = false, HASPRE = true, HASROW = false;
    const GAS unsigned char* P4; GAS bf16* MP; GAS bf16* MG; float sc; int out8;
    struct Pre { v2u g; v4u p; };
    __device__ __forceinline__ void pre(const Unit& u, int r, int c, Pre& q) const {
        const size_t row = (size_t)u.pm * 256 + r; const int col = u.pn * 256 + c;
        q.g = *(const GAS v2u*)(P4 + row * 6144 + u.aux * 2048 + col);
        if (u.aux > 0) q.p = *(const GAS v4u*)(MP + row * D + col); else { unsigned zz = 0u; asm volatile("" : "+v"(zz)); q.p = (v4u){zz, zz, zz, zz}; }
    }
    __device__ __forceinline__ void post(const Unit& u, int r, int c, f32x4 v0, f32x4 v1, const Pre& q) const {
        const size_t row = (size_t)u.pm * 256 + r; const int col = u.pn * 256 + c;
        f32x4 a = (f32x4){(float)(q.g.x & 255u), (float)((q.g.x >> 8) & 255u), (float)((q.g.x >> 16) & 255u), (float)(q.g.x >> 24)} * (v0 * sc) + (f32x4){bflo(q.p.x), bfhi(q.p.x), bflo(q.p.y), bfhi(q.p.y)};
        f32x4 b = (f32x4){(float)(q.g.y & 255u), (float)((q.g.y >> 8) & 255u), (float)((q.g.y >> 16) & 255u), (float)(q.g.y >> 24)} * (v1 * sc) + (f32x4){bflo(q.p.z), bfhi(q.p.z), bflo(q.p.w), bfhi(q.p.w)};
        if (u.aux < 2) *(GAS v4u*)(MP + row * D + col) = pack8(a, b);
        else if (out8) { a = a * MRG8_SCALE; b = b * MRG8_SCALE; *(GAS v2u*)((GAS unsigned char*)MG + (WS_H8 - WS_H) + row * D + col) = (v2u){pk4_fp8(a[0], a[1], a[2], a[3]), pk4_fp8(b[0], b[1], b[2], b[3])}; }
        else *(GAS v4u*)(MG + row * D + col) = pack8(a, b);
    }
    __device__ __forceinline__ void tile8(const Unit& u, int r, int c, f32x4 v0, f32x4 v1) const { Pre q; pre(u, r, c, q); post(u, r, c, v0, v1, q); }
};
struct EpiOut {
    static constexpr bool PAIR = false, HASPRE = true, HASROW = false;
    const GAS float* xin; GAS bf16* xb; int in32; float sc;
    struct Pre { f32x4 a, b; };
    __device__ __forceinline__ void pre(const Unit& u, int r, int c, Pre& q) const {
        const size_t off = ((size_t)u.pm * 256 + r) * D + u.pn * 256 + c;
        if (in32) { q.a = *(const GAS f32x4*)(xin + off); q.b = *(const GAS f32x4*)(xin + off + 4); }
        else { const v4u t = *(const GAS v4u*)(xb + off); q.a = (f32x4){bflo(t.x), bfhi(t.x), bflo(t.y), bfhi(t.y)}; q.b = (f32x4){bflo(t.z), bfhi(t.z), bflo(t.w), bfhi(t.w)}; }
    }
    __device__ __forceinline__ void post(const Unit& u, int r, int c, f32x4 v0, f32x4 v1, const Pre& q) const {
        const size_t off = ((size_t)u.pm * 256 + r) * D + u.pn * 256 + c; *(GAS v4u*)(xb + off) = pack8(q.a + v0 * sc, q.b + v1 * sc);
    }
    __device__ __forceinline__ void tile8(const Unit& u, int r, int c, f32x4 v0, f32x4 v1) const { Pre q; pre(u, r, c, q); post(u, r, c, v0, v1, q); }
};
struct EpiMoe1 {
    static constexpr bool PAIR = true, HASPRE = false, HASROW = true;
    const GAS float* roww; GAS bf16* HID;
    typedef f32x2 RowT;
    __device__ __forceinline__ f32x2 rowload(const Unit& u, int r) const { const bool ok = r < u.nv; const GAS float* p = roww + (size_t)(u.aux + (ok ? r : 0)) * 4; const f32x2 v = (f32x2){p[u.pn >> 2], p[2]}; return ok ? v : (f32x2){0.f, 0.f}; }
    __device__ __forceinline__ void pair8w(const Unit& u, int r, int c, f32x4 g0, f32x4 g1, f32x4 u0, f32x4 u1, f32x2 wr2) const {
        const size_t row = (size_t)u.pm * 256 + r; const int seg = u.pn >> 2; const float rstd = wr2[1] * (1.f / WGU8_SCALE), w = wr2[0] * rstd * HID8_SCALE;
        f32x4 a, b;
#pragma unroll
        for (int k = 0; k < 4; ++k) { const float ga = g0[k] * rstd, gb = g1[k] * rstd; a[k] = ga * sigmoidf_(ga) * u0[k] * w; b[k] = gb * sigmoidf_(gb) * u1[k] * w; }
        if (MOE2_FP8) *(GAS v2u*)((GAS unsigned char*)HID + row * 1024 + seg * 512 + (u.pn & 3) * 128 + c) = (v2u){pk4_fp8(a[0], a[1], a[2], a[3]), pk4_fp8(b[0], b[1], b[2], b[3])};
        else *(GAS v4u*)(HID + row * 1024 + seg * 512 + (u.pn & 3) * 128 + c) = pack8(a, b);
    }
    __device__ __forceinline__ void pair8(const Unit& u, int r, int c, f32x4 g0, f32x4 g1, f32x4 u0, f32x4 u1) const { pair8w(u, r, c, g0, g1, u0, u1, rowload(u, r)); }
};
struct EpiMoe2 {
    static constexpr bool PAIR = false, HASPRE = true, HASROW = true;
    const GAS int* perm; GAS bf16* xb; GAS float* xout; int last;
    typedef int RowT;
    struct Pre { v4u p; };
    __device__ __forceinline__ int rowload(const Unit& u, int r) const { const bool ok = r < u.nv; const int tok = perm[u.aux + (ok ? r : 0)]; return ok ? tok : -1; }
    __device__ __forceinline__ void pre(const Unit& u, int r, int c, Pre& q, int tok) const {
        q.p = *(const GAS v4u*)(xb + (size_t)(tok < 0 ? 0 : tok) * D + u.pn * 256 + c);
    }
    __device__ __forceinline__ void post(const Unit& u, int r, int c, f32x4 v0, f32x4 v1, const Pre& q, int tok) const {
        if (tok < 0) return;
        const float sc = 1.f / (HID8_SCALE * WD8_SCALE); const size_t off = (size_t)tok * D + u.pn * 256 + c;
        const f32x4 a = (f32x4){bflo(q.p.x), bfhi(q.p.x), bflo(q.p.y), bfhi(q.p.y)} + v0 * sc, b = (f32x4){bflo(q.p.z), bfhi(q.p.z), bflo(q.p.w), bfhi(q.p.w)} + v1 * sc;
        if (last) { *(GAS f32x4*)(xout + off) = a; *(GAS f32x4*)(xout + off + 4) = b; }
        else *(GAS v4u*)(xb + off) = pack8(a, b);
    }
    __device__ __forceinline__ void tile8(const Unit& u, int r, int c, f32x4 v0, f32x4 v1) const { Pre q; const int tok = rowload(u, r); pre(u, r, c, q, tok); post(u, r, c, v0, v1, q, tok); }
};

template <class Epi, class Sched, int NSEG>
__device__ __forceinline__ void gemm_simple(int lda, int ldb, int nt, const Sched& S, const Epi& E) {
    const int tid = threadIdx.x, wid = tid >> 6, lane = tid & 63, fr = lane & 15, fq = lane >> 4;
    Unit u;
    for (int i = 0; S.next(i, u); ++i) {
        constexpr int NCG = Epi::PAIR ? 4 : 8;
        for (int sub = wid; sub < 16 * NCG; sub += NWAVES) {
            const int rt = sub / NCG, cg = sub % NCG;
            f32x4 acc[4];
#pragma unroll
            for (int k = 0; k < 4; ++k) acc[k] = (f32x4){0.f, 0.f, 0.f, 0.f};
            for (int seg = 0; seg < NSEG; ++seg) {
                size_t arow = (size_t)(rt * 16 + fr) * lda;
                if constexpr (Sched::GATHER) { const int R1[2] = {(rt * 16 + fr) & 127, 0}; const int C1[2] = {0, 0}; unsigned o[2][2]; S.aoffs(u, R1, C1, o); arow = o[(rt * 16 + fr) >> 7][0]; }
                const GAS char* Ab = (seg ? u.A2 : u.A) + arow + fq * 16;
                const GAS char* Bb = (seg ? u.B2 : u.B) + fq * 16;
                const int brow0 = cg * 32 + 8 * (fr >> 2) + (fr & 3);
                for (int ks = 0; ks < nt * 2; ++ks) {
                    const bf16x8 a = *(const GAS bf16x8*)(Ab + ks * 64);
#pragma unroll
                    for (int n = 0; n < 2; ++n) {
                        const bf16x8 w = *(const GAS bf16x8*)(Bb + (size_t)(brow0 + 4 * n) * ldb + ks * 64);
                        acc[n] = __builtin_amdgcn_mfma_f32_16x16x32_bf16(w, a, acc[n], 0, 0, 0);
                        if (Epi::PAIR) { const bf16x8 w2 = *(const GAS bf16x8*)(Bb + (size_t)(128 + brow0 + 4 * n) * ldb + ks * 64);
                            acc[2 + n] = __builtin_amdgcn_mfma_f32_16x16x32_bf16(w2, a, acc[2 + n], 0, 0, 0); }
                    }
                }
            }
            if constexpr (Epi::PAIR) E.pair8(u, rt * 16 + fr, cg * 32 + 8 * fq, acc[0], acc[1], acc[2], acc[3]);
            else E.tile8(u, rt * 16 + fr, cg * 32 + 8 * fq, acc[0], acc[1]);
        }
    }
}

#ifndef PG8_ALIGN_EPI
#define PG8_ALIGN_EPI 1
#endif
namespace pg8 {
constexpr int BM = 256, BK = 64, HALF = 128, HTB = HALF * BK * 2, STAGE_BYTES = 8 * HTB;
__device__ __forceinline__ int lds_byte(int r, int c) { const int st = (r >> 4) * 2 + (c >> 5), rr = r & 15, cc = c & 31, ob = rr * 64 + cc * 2; return st * 1024 + (ob ^ (((ob >> 9) & 1) << 5)); }
__device__ __forceinline__ void stage_rc(int b, int& R, int& C) { const int st = b / 1024, sb = b % 1024, swz = sb ^ (((sb >> 9) & 1) << 5); R = (st >> 1) * 16 + swz / 64; C = (st & 1) * 32 + (swz % 64) / 2; }
__device__ __forceinline__ int perm32(int rho) { const int n = rho >> 4, i = rho & 15; return 8 * (i >> 2) + 4 * n + (i & 3); }

__device__ __forceinline__ void glds_saddr(const GAS char* gbase, unsigned voff, unsigned lds_dst) {
    unsigned keep;
    asm volatile("s_mov_b32 %0, m0\n\ts_mov_b32 m0, %3\n\ts_nop 0\n\tglobal_load_lds_dwordx4 %1, %2\n\ts_mov_b32 m0, %0" : "=&s"(keep) : "v"(voff), "s"(gbase), "s"(lds_dst) : "memory");
}
template <class Epi> __device__ __forceinline__ void run_epi(const Epi& E, const f32x4 (&acc)[2][2][4][2], const Unit& u, int wr, int wc, int fr, int fq) {
    if constexpr (Epi::PAIR && Epi::HASROW) {
        typename Epi::RowT rv[2][4];
#pragma unroll
        for (int ai = 0; ai < 2; ++ai)
#pragma unroll
            for (int m = 0; m < 4; ++m) rv[ai][m] = E.rowload(u, ai * HALF + wr * 64 + m * 16 + fr);
#pragma unroll
        for (int ai = 0; ai < 2; ++ai)
#pragma unroll
            for (int m = 0; m < 4; ++m) {
                int r = ai * HALF + wr * 64 + m * 16 + fr; asm volatile("" : "+v"(r) :: "memory");
                E.pair8w(u, r, wc * 32 + 8 * fq, acc[ai][0][m][0], acc[ai][0][m][1], acc[ai][1][m][0], acc[ai][1][m][1], rv[ai][m]);
                asm volatile("" ::: "memory");
            }
    } else if constexpr (Epi::HASPRE) {
        typename std::conditional<Epi::HASROW, int, char>::type rv[2][4];
        if constexpr (Epi::HASROW) {
#pragma unroll
            for (int ai = 0; ai < 2; ++ai)
#pragma unroll
                for (int m = 0; m < 4; ++m) rv[ai][m] = E.rowload(u, ai * HALF + wr * 64 + m * 16 + fr);
        }
#pragma unroll
        for (int ai = 0; ai < 2; ++ai)
#pragma unroll
            for (int mp = 0; mp < 2; ++mp) {
                int r0 = ai * HALF + wr * 64 + (2 * mp) * 16 + fr; asm volatile("" : "+v"(r0) :: "memory");
                const int c0 = wc * 32 + 8 * fq;
                typename Epi::Pre q[2][2];
                if constexpr (Epi::HASROW) {
#pragma unroll
                    for (int mm = 0; mm < 2; ++mm)
#pragma unroll
                        for (int bj = 0; bj < 2; ++bj) E.pre(u, r0 + 16 * mm, bj * HALF + c0, q[mm][bj], rv[ai][2 * mp + mm]);
#pragma unroll
                    for (int mm = 0; mm < 2; ++mm)
#pragma unroll
                        for (int bj = 0; bj < 2; ++bj) E.post(u, r0 + 16 * mm, bj * HALF + c0, acc[ai][bj][2 * mp + mm][0], acc[ai][bj][2 * mp + mm][1], q[mm][bj], rv[ai][2 * mp + mm]);
                } else {
#pragma unroll
                for (int mm = 0; mm < 2; ++mm)
#pragma unroll
                    for (int bj = 0; bj < 2; ++bj) E.pre(u, r0 + 16 * mm, bj * HALF + c0, q[mm][bj]);
#pragma unroll
                for (int mm = 0; mm < 2; ++mm)
#pragma unroll
                    for (int bj = 0; bj < 2; ++bj) E.post(u, r0 + 16 * mm, bj * HALF + c0, acc[ai][bj][2 * mp + mm][0], acc[ai][bj][2 * mp + mm][1], q[mm][bj]);
                }
                asm volatile("" ::: "memory");
            }
    } else {
    if constexpr (!Epi::PAIR && Epi::WIDE8) {
        if (E.wide(u)) {
#pragma unroll
            for (int ai = 0; ai < 2; ++ai)
#pragma unroll
                for (int mp = 0; mp < 2; ++mp) {
                    int r0 = ai * HALF + wr * 64 + (2 * mp) * 16 + fr; asm volatile("" : "+v"(r0) :: "memory");
#pragma unroll
                    for (int bj = 0; bj < 2; ++bj) {
                        v2u a = E.pack8u(acc[ai][bj][2 * mp][0], acc[ai][bj][2 * mp][1]), b = E.pack8u(acc[ai][bj][2 * mp + 1][0], acc[ai][bj][2 * mp + 1][1]);
                        asm volatile("s_nop 1\n\tv_permlane16_swap_b32 %0, %1" : "+v"(a.x), "+v"(b.x));
                        asm volatile("s_nop 1\n\tv_permlane16_swap_b32 %0, %1" : "+v"(a.y), "+v"(b.y));
                        const int odd = fq & 1;
                        E.store16(u, r0 + 16 * odd, bj * HALF + wc * 32 + 8 * (fq - odd), (v4u){a.x, a.y, b.x, b.y});
                    }
                    asm volatile("" ::: "memory");
                }
            return;
        }
    }
#pragma unroll
    for (int ai = 0; ai < 2; ++ai)
#pragma unroll
        for (int m = 0; m < 4; ++m) {
            int r = ai * HALF + wr * 64 + m * 16 + fr; asm volatile("" : "+v"(r) :: "memory");
            if constexpr (Epi::PAIR) E.pair8(u, r, wc * 32 + 8 * fq, acc[ai][0][m][0], acc[ai][0][m][1], acc[ai][1][m][0], acc[ai][1][m][1]);
            else {
#pragma unroll
                for (int bj = 0; bj < 2; ++bj) { E.tile8(u, r, bj * HALF + wc * 32 + 8 * fq, acc[ai][bj][m][0], acc[ai][bj][m][1]); asm volatile("" ::: "memory"); }
            }
            asm volatile("" ::: "memory");
        }
    }
}

#define PG8_KPTR(base, base2, tau) ((NSEG == 2 && (tau) >= nt) ? (base2) + (size_t)((tau) - nt) * kstep : (base) + (size_t)(tau) * kstep)
typedef int v8i __attribute__((ext_vector_type(8)));
template <class Epi, class Sched, int NSEG, bool FP8 = false>
__device__ __forceinline__ void gemm_fast(LAS unsigned char* lds, const int lda, const int ldb, const int nt, const Sched& S, const Epi& E) {
    int tid = threadIdx.x; asm volatile("" : "+v"(tid));
    const int wid = __builtin_amdgcn_readfirstlane(tid >> 6), lane = tid & 63, wr = wid >> 2, wc = wid & 3, fr = lane & 15, fq = lane >> 4;
    const int NT = NSEG * nt;
    unsigned voffB[2]; int RA[2], CA[2];
#pragma unroll
    for (int i = 0; i < 2; ++i) { int R, C; stage_rc(tid * 16 + i * 8192, R, C); const int Rb = (R & ~31) + perm32(R & 31);
        RA[i] = R; CA[i] = C; voffB[i] = (unsigned)(Rb * ldb + C * 2); }
    unsigned vA[2][2], vAn[2][2];
#pragma unroll
    for (int h = 0; h < 2; ++h)
#pragma unroll
        for (int i = 0; i < 2; ++i) { vA[h][i] = (unsigned)((h * HALF + RA[i]) * lda + CA[i] * 2); vAn[h][i] = vA[h][i]; }
    const size_t kstep = (size_t)(BK * 2);
    const size_t hstepB = (size_t)HALF * ldb;
    const unsigned ldsw = (unsigned)wid * 1024u;
    const unsigned lds0 = (unsigned)(size_t)lds;
    const int aoff = lds_byte(wr * 64 + fr, fq * 8), boff = lds_byte(wc * 32 + fr, fq * 8);
    const int aoff8a = aoff, boff8a = boff;
#define PG8_SA(b, h) (((b) * 2 + (h)) * HTB)
#define PG8_SB(b, h) ((4 + (b) * 2 + (h)) * HTB)
#define PG8_STAGE(bufoff, gbase, voff) do { _Pragma("unroll") for (int _i = 0; _i < 2; ++_i) \
        glds_saddr((const GAS char*)(gbase), (voff)[_i], lds0 + (unsigned)((bufoff) + _i * 8192) + ldsw); } while (0)
#define PG8_LDA(dst, b, h) do { _Pragma("unroll") for (int m = 0; m < 4; ++m) _Pragma("unroll") for (int k = 0; k < 2; ++k) dst[m][k] = *(const LAS bf16x8*)(lds + PG8_SA(b, h) + aoff + m * 2048 + k * 1024); } while (0)
#define PG8_LDB(dst, b, h) do { _Pragma("unroll") for (int n = 0; n < 2; ++n) _Pragma("unroll") for (int k = 0; k < 2; ++k) dst[n][k] = *(const LAS bf16x8*)(lds + PG8_SB(b, h) + boff + n * 2048 + k * 1024); } while (0)
#define PG8_MMA(ai, bj, At, Bt) do { __builtin_amdgcn_s_setprio(1); _Pragma("unroll") for (int m = 0; m < 4; ++m) _Pragma("unroll") for (int n = 0; n < 2; ++n) _Pragma("unroll") for (int k = 0; k < 2; ++k) \
        acc[ai][bj][m][n] = __builtin_amdgcn_mfma_f32_16x16x32_bf16(Bt[n][k], At[m][k], acc[ai][bj][m][n], 0, 0, 0); __builtin_amdgcn_s_setprio(0); } while (0)
#define PG8_LD8(dst, off) do { const v4u lo_ = *(const LAS v4u*)(lds + (off)); (dst)[0] = (int)lo_.x; (dst)[1] = (int)lo_.y; (dst)[2] = (int)lo_.z; (dst)[3] = (int)lo_.w; } while (0)
#define PG8_LD8H(dst, off) do { const v4u hi_ = *(const LAS v4u*)(lds + (off)); (dst)[4] = (int)hi_.x; (dst)[5] = (int)hi_.y; (dst)[6] = (int)hi_.z; (dst)[7] = (int)hi_.w; } while (0)
#define PG8_LDA8(dst, b, h) do { _Pragma("unroll") for (int m = 0; m < 4; ++m) { PG8_LD8(dst[m], PG8_SA(b, h) + aoff8a + m * 2048); PG8_LD8H(dst[m], PG8_SA(b, h) + aoff8a + 1024 + m * 2048); } } while (0)
#define PG8_LDB8(dst, b, h) do { _Pragma("unroll") for (int n = 0; n < 2; ++n) { PG8_LD8(dst[n], PG8_SB(b, h) + boff8a + n * 2048); PG8_LD8H(dst[n], PG8_SB(b, h) + boff8a + 1024 + n * 2048); } } while (0)
#define PG8_MMA8(ai, bj, A8_, B8_) do { __builtin_amdgcn_s_setprio(1); _Pragma("unroll") for (int m = 0; m < 4; ++m) _Pragma("unroll") for (int n = 0; n < 2; ++n) \
        asm volatile("v_mfma_scale_f32_16x16x128_f8f6f4 %0, %1, %2, %0, %3, %3 op_sel_hi:[0,0,0]" : "+v"(acc[ai][bj][m][n]) : "v"(B8_[n]), "v"(A8_[m]), "v"(sc127)); __builtin_amdgcn_s_setprio(0); } while (0)
#ifdef DRAIN_ALL
#define PG8_WAIT_V(n) asm volatile("s_waitcnt vmcnt(0)" ::: "memory")
#else
#define PG8_WAIT_V(n) asm volatile("s_waitcnt vmcnt(" #n ")" ::: "memory")
#endif
#define PG8_WAIT_L(n) asm volatile("s_waitcnt lgkmcnt(" #n ")" ::: "memory")
#define PG8_BAR __builtin_amdgcn_s_barrier()
#define PG8_SCHED __builtin_amdgcn_sched_barrier(0)
    Unit cur, nxt; int ui = 0;
    if (!S.next(0, cur)) return;
    if constexpr (Sched::GATHER) S.aoffs(cur, RA, CA, vA);
    f32x4 acc[2][2][4][2];
#pragma unroll
    for (int a = 0; a < 2; ++a)
#pragma unroll
        for (int b = 0; b < 2; ++b)
#pragma unroll
            for (int m = 0; m < 4; ++m)
#pragma unroll
                for (int n = 0; n < 2; ++n) acc[a][b][m][n] = (f32x4){0.f, 0.f, 0.f, 0.f};
    if constexpr (FP8) {
#pragma unroll
        for (int a = 0; a < 2; ++a)
#pragma unroll
            for (int b = 0; b < 2; ++b)
#pragma unroll
                for (int m = 0; m < 4; ++m)
#pragma unroll
                    for (int n = 0; n < 2; ++n) asm volatile("" : "+v"(acc[a][b][m][n]));
        asm volatile("s_nop 7\n\ts_nop 7" ::: "memory");
    }
    int sc127 = 127; asm volatile("" : "+v"(sc127));
    bf16x8 At[4][2], B0[2][2], B1[2][2]; v8i A8[4], B80[2], B81[2];
    {
        const GAS char* cA = cur.A; const GAS char* cB = cur.B;
        PG8_STAGE(PG8_SB(0, 0), cB, voffB); PG8_STAGE(PG8_SB(0, 1), cB + hstepB, voffB); PG8_STAGE(PG8_SA(0, 0), cA, vA[0]); PG8_STAGE(PG8_SA(0, 1), cA, vA[1]);
        if (wr == 1) PG8_BAR;
        PG8_WAIT_V(2); PG8_BAR;
        PG8_STAGE(PG8_SB(1, 0), cB + kstep, voffB); PG8_STAGE(PG8_SA(1, 0), cA + kstep, vA[0]); PG8_STAGE(PG8_SB(1, 1), cB + hstepB + kstep, voffB);
        PG8_WAIT_V(6); PG8_BAR;
    }
    for (;;) {
        const bool has_next = S.next(ui + 1, nxt);
        if (!has_next) nxt = cur;
        if constexpr (Sched::GATHER) { if (has_next) S.aoffs(nxt, RA, CA, vAn); else {
#pragma unroll
            for (int h = 0; h < 2; ++h)
#pragma unroll
                for (int i = 0; i < 2; ++i) vAn[h][i] = vA[h][i]; } }
        for (int t = 0; t < NT; t += 2) {
            const bool last = (t == NT - 2);
            const GAS char* a1 = PG8_KPTR(cur.A, cur.A2, t + 1);
            const GAS char* a2 = last ? nxt.A : PG8_KPTR(cur.A, cur.A2, t + 2); const GAS char* b2 = last ? nxt.B : PG8_KPTR(cur.B, cur.B2, t + 2);
            const GAS char* a3 = a2 + kstep; const GAS char* b3 = b2 + kstep;
            unsigned sa0[2], sa1[2];
#pragma unroll
            for (int i = 0; i < 2; ++i) { if constexpr (Sched::GATHER) { sa0[i] = last ? vAn[0][i] : vA[0][i]; sa1[i] = last ? vAn[1][i] : vA[1][i]; } else { sa0[i] = vA[0][i]; sa1[i] = vA[1][i]; } }
            if constexpr (FP8) { PG8_LDB8(B80, 0, 0); PG8_LDB8(B81, 0, 1); PG8_SCHED; PG8_LDA8(A8, 0, 0); } else { PG8_LDB(B0, 0, 0); PG8_LDB(B1, 0, 1); PG8_SCHED; PG8_LDA(At, 0, 0); } PG8_STAGE(PG8_SA(1, 1), a1, vA[1]);
            PG8_WAIT_V(8); PG8_WAIT_L(0); PG8_BAR; if constexpr (FP8) { PG8_MMA8(0, 0, A8, B80); PG8_MMA8(0, 1, A8, B81); } else { PG8_MMA(0, 0, At, B0); PG8_MMA(0, 1, At, B1); } PG8_BAR; PG8_SCHED;
            if constexpr (FP8) { PG8_LDA8(A8, 0, 1); } else { PG8_LDA(At, 0, 1); } PG8_STAGE(PG8_SB(0, 0), b2, voffB); PG8_STAGE(PG8_SB(0, 1), b2 + hstepB, voffB); PG8_STAGE(PG8_SA(0, 0), a2, sa0);
            PG8_WAIT_V(8); PG8_WAIT_L(0); PG8_BAR; if constexpr (FP8) { PG8_MMA8(1, 0, A8, B80); PG8_MMA8(1, 1, A8, B81); } else { PG8_MMA(1, 0, At, B0); PG8_MMA(1, 1, At, B1); } PG8_BAR; PG8_SCHED;
            if constexpr (FP8) { PG8_LDB8(B80, 1, 0); PG8_LDB8(B81, 1, 1); PG8_SCHED; PG8_LDA8(A8, 1, 0); } else { PG8_LDB(B0, 1, 0); PG8_LDB(B1, 1, 1); PG8_SCHED; PG8_LDA(At, 1, 0); } PG8_STAGE(PG8_SA(0, 1), a2, sa1);
            PG8_WAIT_V(8); PG8_WAIT_L(0); PG8_BAR; if constexpr (FP8) { PG8_MMA8(0, 0, A8, B80); PG8_MMA8(0, 1, A8, B81); } else { PG8_MMA(0, 0, At, B0); PG8_MMA(0, 1, At, B1); } PG8_BAR; PG8_SCHED;
            if constexpr (FP8) { PG8_LDA8(A8, 1, 1); } else { PG8_LDA(At, 1, 1); } PG8_STAGE(PG8_SB(1, 0), b3, voffB); PG8_STAGE(PG8_SB(1, 1), b3 + hstepB, voffB); PG8_STAGE(PG8_SA(1, 0), a3, sa0);
            PG8_WAIT_V(8); PG8_WAIT_L(0); PG8_BAR; if constexpr (FP8) { PG8_MMA8(1, 0, A8, B80); PG8_MMA8(1, 1, A8, B81); } else { PG8_MMA(1, 0, At, B0); PG8_MMA(1, 1, At, B1); } PG8_BAR; PG8_SCHED;
        }
        if (PG8_ALIGN_EPI) { if (wr == 0) PG8_BAR; }
        if constexpr (FP8) asm volatile("s_nop 7\n\ts_nop 7\n\ts_nop 7\n\ts_nop 7" ::: "memory");
        { int t2 = threadIdx.x; asm volatile("" : "+v"(t2)); const int l2 = t2 & 63; run_epi(E, acc, cur, wr, wc, l2 & 15, l2 >> 4); }
        if (!has_next) break;
#pragma unroll
        for (int a = 0; a < 2; ++a)
#pragma unroll
            for (int b = 0; b < 2; ++b)
#pragma unroll
                for (int m = 0; m < 4; ++m)
#pragma unroll
                    for (int n = 0; n < 2; ++n) acc[a][b][m][n] = (f32x4){0.f, 0.f, 0.f, 0.f};
        if constexpr (FP8) {
#pragma unroll
            for (int a = 0; a < 2; ++a)
#pragma unroll
                for (int b = 0; b < 2; ++b)
#pragma unroll
                    for (int m = 0; m < 4; ++m)
#pragma unroll
                        for (int n = 0; n < 2; ++n) asm volatile("" : "+v"(acc[a][b][m][n]));
            asm volatile("s_nop 7\n\ts_nop 7" ::: "memory");
        }
        cur = nxt; ++ui;
        if constexpr (Sched::GATHER) {
#pragma unroll
            for (int h = 0; h < 2; ++h)
#pragma unroll
                for (int i = 0; i < 2; ++i) vA[h][i] = vAn[h][i]; }
        if (PG8_ALIGN_EPI) { if (wr == 1) PG8_BAR; }
    }
    PG8_WAIT_V(0);
    if (!PG8_ALIGN_EPI) { if (wr == 0) PG8_BAR; }
    PG8_BAR;
#undef PG8_SA
#undef PG8_SB
#undef PG8_STAGE
#undef PG8_LDA
#undef PG8_LDA8
#undef PG8_LDB8
#undef PG8_LD8
#undef PG8_LD8H
#undef PG8_MMA8
#undef PG8_LDB
#undef PG8_MMA
#undef PG8_WAIT_V
#undef PG8_WAIT_L
#undef PG8_BAR
#undef PG8_SCHED
}
}

#ifndef REPEAT_MASK
#define REPEAT_MASK 0
#endif
#define NREP(k) (((REPEAT_MASK >> (k)) & 1) ? 2 : 1)
#ifndef FASTMASK
#define FASTMASK 0x19A
#endif
template <int PH, class Epi, class Sched, int NSEG>
__device__ __forceinline__ void gemm_run(LAS unsigned char* lds, int lda, int ldb, int nt, const Sched& S, const Epi& E) {
    if constexpr ((FASTMASK >> PH) & 1) pg8::gemm_fast<Epi, Sched, NSEG>(lds, lda, ldb, nt, S, E);
    else gemm_simple<Epi, Sched, NSEG>(lda, ldb, nt, S, E);
}

struct Args { const float* in[24]; float* out; unsigned char* ws; int ph_lo, ph_hi; };
struct Ctx {
    LAS unsigned char* lds; volatile LAS unsigned* lw;
    GAS float* out; GAS unsigned char* ws; gu32* ctl;
    int tid, lane, wave, vcu, G, bid; float zf;
};

__device__ __forceinline__ void relaunder(Ctx& C) {
    int t = threadIdx.x; asm volatile("" : "+v"(t)); C.tid = t; C.lane = t & 63; C.wave = __builtin_amdgcn_readfirstlane(t >> 6);
    float z = 0.f; asm volatile("" : "+v"(z)); C.zf = z;
    asm volatile("" : "+s"(C.out), "+s"(C.ws), "+s"(C.ctl), "+s"(C.vcu), "+s"(C.G), "+s"(C.bid));
}
__device__ __forceinline__ unsigned dpp_xor1(unsigned v) { return (unsigned)__builtin_amdgcn_update_dpp(0, (int)v, 0xB1, 0xf, 0xf, true); }
__device__ __forceinline__ void rms_row_to_bf16(const GAS float* xrow, const GAS float* gain, GAS bf16* orow, int lane, GAS unsigned char* orow8 = nullptr) {
    const GAS f32x4* xr = (const GAS f32x4*)xrow + lane; const GAS f32x4* gr = (const GAS f32x4*)gain + lane;
    f32x4 v[8]; float s = 0.f;
#pragma unroll
    for (int j = 0; j < 8; ++j) { v[j] = xr[64 * j]; s += (v[j].x * v[j].x + v[j].y * v[j].y) + (v[j].z * v[j].z + v[j].w * v[j].w); }
    const float rstd = 1.f / sqrtf(wave_sum(s, lane) * (1.f / D) + EPS);
    const bool odd = lane & 1;
#pragma unroll
    for (int i = 0; i < 4; ++i) { const f32x4 a = v[2 * i] * rstd * gr[64 * (2 * i)], b = v[2 * i + 1] * rstd * gr[64 * (2 * i + 1)];
        const unsigned a0 = pk2(a.x, a.y), a1 = pk2(a.z, a.w), b0 = pk2(b.x, b.y), b1 = pk2(b.z, b.w);
        const unsigned r0 = dpp_xor1(odd ? a0 : b0), r1 = dpp_xor1(odd ? a1 : b1);
        const int e0 = odd ? 4 * (lane - 1 + 64 * (2 * i + 1)) : 4 * (lane + 64 * (2 * i));
        *(GAS v4u*)(orow + e0) = odd ? (v4u){r0, r1, b0, b1} : (v4u){a0, a1, r0, r1};
        if (orow8) { const unsigned fa = pk4_fp8(a.x, a.y, a.z, a.w), fb = pk4_fp8(b.x, b.y, b.z, b.w); const unsigned rf = dpp_xor1(odd ? fa : fb);
            *(GAS v2u*)(orow8 + e0) = odd ? (v2u){rf, fb} : (v2u){fa, rf}; } }
}
__device__ __forceinline__ void rms_row_from_bf16(const GAS bf16* xrow, const GAS float* gain, GAS bf16* orow, int lane, GAS unsigned char* orow8) {
    const GAS v4u* xr = (const GAS v4u*)xrow + lane; const GAS f32x4* gr = (const GAS f32x4*)gain + 2 * lane;
    v4u v[4]; float s = 0.f;
#pragma unroll
    for (int j = 0; j < 4; ++j) { v[j] = xr[64 * j]; const float a0 = bflo(v[j].x), a1 = bfhi(v[j].x), a2 = bflo(v[j].y), a3 = bfhi(v[j].y), a4 = bflo(v[j].z), a5 = bfhi(v[j].z), a6 = bflo(v[j].w), a7 = bfhi(v[j].w);
        s += ((a0 * a0 + a1 * a1) + (a2 * a2 + a3 * a3)) + ((a4 * a4 + a5 * a5) + (a6 * a6 + a7 * a7)); }
    const float rstd = 1.f / sqrtf(wave_sum(s, lane) * (1.f / D) + EPS);
#pragma unroll
    for (int j = 0; j < 4; ++j) { const f32x4 g0 = gr[128 * j] * rstd, g1 = gr[128 * j + 1] * rstd;
        const f32x4 a = (f32x4){bflo(v[j].x), bfhi(v[j].x), bflo(v[j].y), bfhi(v[j].y)} * g0, b = (f32x4){bflo(v[j].z), bfhi(v[j].z), bflo(v[j].w), bfhi(v[j].w)} * g1;
        ((GAS v4u*)orow)[64 * j + lane] = pack8(a, b);
        ((GAS v2u*)orow8)[64 * j + lane] = (v2u){pk4_fp8(a[0], a[1], a[2], a[3]), pk4_fp8(b[0], b[1], b[2], b[3])}; }
}
#ifndef LATE_PCT
#define LATE_PCT 2
#endif
struct WTile { const GAS float* W; GAS unsigned char* dst; int K, N, kind, rowmode, nsub, k0, n0; float sc; };
__device__ __forceinline__ void conv_tile_load(const WTile& t, f32x4 (&x)[16], int wave, int lane) {
    const GAS float* p = t.W + (size_t)(t.k0 + 16 * wave) * t.N + t.n0 + 4 * lane;
#pragma unroll
    for (int i = 0; i < 16; ++i) x[i] = *(const GAS f32x4*)(p + (size_t)i * t.N);
}
__device__ __forceinline__ void conv_tile_stage(const WTile& t, const f32x4 (&x)[16], LAS unsigned* L, int wave, int lane) {
    if (t.kind == 0) {
#pragma unroll
        for (int p = 0; p < 8; ++p)
#pragma unroll
            for (int e = 0; e < 4; ++e) L[(lane + 64 * e) * 65 + 8 * wave + p] = pk2(x[2 * p][e], x[2 * p + 1][e]);
    } else {
        const float sc = t.sc;
#pragma unroll
        for (int q = 0; q < 4; ++q)
#pragma unroll
            for (int e = 0; e < 4; ++e) L[(lane + 64 * e) * 33 + 4 * wave + q] = pk4_fp8(x[4 * q][e] * sc, x[4 * q + 1][e] * sc, x[4 * q + 2][e] * sc, x[4 * q + 3][e] * sc);
    }
}
__device__ __forceinline__ void conv_tile_store(const WTile& t, const LAS unsigned* L, int wave, int lane) {
    if (t.kind == 0) {
        const int c = lane & 15, rs = lane >> 4;
#pragma unroll 2
        for (int r = 0; r < 8; ++r) { const int np = 32 * wave + 4 * r + rs, n = 4 * (np & 63) + (np >> 6) + t.n0 - t.nsub;
            const LAS unsigned* p = L + np * 65 + 4 * c; v4u o; o.x = p[0]; o.y = p[1]; o.z = p[2]; o.w = p[3];
            *(GAS v4u*)(t.dst + ((size_t)n * t.K + t.k0) * 2 + 16 * c) = o; }
    } else {
        const int c = lane & 7, rs = lane >> 3;
#pragma unroll 2
        for (int r = 0; r < 4; ++r) { const int np = 32 * wave + 8 * r + rs; int n = 4 * (np & 63) + (np >> 6) + t.n0 - t.nsub;
            if (t.rowmode) n = 256 * (n >> 7) + (n & 127) + (t.rowmode == 2 ? 128 : 0);
            const LAS unsigned* p = L + np * 33 + 4 * c; v4u o; o.x = p[0]; o.y = p[1]; o.z = p[2]; o.w = p[3];
            *(GAS v4u*)(t.dst + (size_t)n * t.K + t.k0 + 16 * c) = o; }
    }
}
constexpr int WT_IN = (D / 128) * (NIN / 256), WT_MKV = (D / 128) * (2048 / 256), WT_BR = (1024 / 128) * (D / 256), WT_OUT = (D / 128) * (D / 256), WT_GU = (D / 128) * (DFF / 256), WT_DN = (DFF / 128) * (D / 256);
constexpr int WT_EARLY = WT_IN + WT_MKV, WT_ALL = WT_EARLY + 3 * WT_BR + WT_OUT + NEXP * (2 * WT_GU + WT_DN);
static_assert(MOE1_FP8 && MOE2_FP8, "the tile converter writes the expert weights as e4m3");
__device__ __forceinline__ void conv_tiles(Ctx& C, const CAS Args* A_, int layer, int tb, int te, int wg, int nwg) {
    LAS unsigned* L = (LAS unsigned*)C.lds;
    const GAS float* w_in = ((const GAS float*)A_->in[5]) + (size_t)layer * D * NIN;
    const GAS float* w_mkv = ((const GAS float*)A_->in[14]) + (size_t)layer * D * 2048;
    const GAS float* w_br = ((const GAS float*)A_->in[15]) + (size_t)layer * 3 * 1024 * D;
    const GAS float* w_out = ((const GAS float*)A_->in[16]) + (size_t)layer * D * D;
    const GAS float* w_g = ((const GAS float*)A_->in[21]) + (size_t)layer * NEXP * D * DFF;
    const GAS float* w_u = ((const GAS float*)A_->in[22]) + (size_t)layer * NEXP * D * DFF;
    const GAS float* w_d = ((const GAS float*)A_->in[23]) + (size_t)layer * NEXP * DFF * D;
    GAS unsigned char* ws = C.ws;
    auto decode = [&](int ti, WTile& t) {
        int r = ti, nbk;
        if (r >= WT_ALL) { r -= WT_ALL;
            const GAS float* w_in2 = w_in + (size_t)D * NIN; const GAS float* w_mkv2 = w_mkv + (size_t)D * 2048;
            if (r < WT_IN) { nbk = NIN / 256; const int nb = r % nbk; const bool f8 = nb >= 8; t = WTile{w_in2, ws + (f8 ? WS_WG8 : WS_WIN), D, NIN, f8 ? 1 : 0, 0, f8 ? 2048 : 0, 128 * (r / nbk), 256 * nb, WG8_SCALE}; return; } r -= WT_IN;
            nbk = 8; t = WTile{w_mkv2, ws + WS_WMKV, D, 2048, 0, 0, 0, 128 * (r / nbk), 256 * (r % nbk), 1.f}; return; }
        if (r < WT_IN) { nbk = NIN / 256; const int nb = r % nbk; const bool f8 = nb >= 8; t = WTile{w_in, ws + (f8 ? WS_WG8 : WS_WIN), D, NIN, f8 ? 1 : 0, 0, f8 ? 2048 : 0, 128 * (r / nbk), 256 * nb, WG8_SCALE}; return; } r -= WT_IN;
        if (r < WT_MKV) { nbk = 8; t = WTile{w_mkv, ws + WS_WMKV, D, 2048, 0, 0, 0, 128 * (r / nbk), 256 * (r % nbk), 1.f}; return; } r -= WT_MKV;
        if (r < 3 * WT_BR) { const int n = r / WT_BR; r -= n * WT_BR; nbk = 8; t = WTile{w_br + (size_t)n * 1024 * D, ws + WS_WBR + (n == 0 ? 0 : (size_t)(n + 1) * D * 1024), 1024, D, n == 0 ? 0 : 1, 0, 0, 128 * (r / nbk), 256 * (r % nbk), WBR8_SCALE}; return; } r -= 3 * WT_BR;
        if (r < WT_OUT) { nbk = 8; t = WTile{w_out, ws + WS_WOUT, D, D, layer == NLAYER - 1 ? 1 : 0, 0, 0, 128 * (r / nbk), 256 * (r % nbk), WOUT8_SCALE}; return; } r -= WT_OUT;
        if (r < NEXP * WT_GU) { const int e = r / WT_GU; r -= e * WT_GU; nbk = 2; t = WTile{w_g + (size_t)e * D * DFF, ws + WS_WGU + (size_t)e * 1024 * D, D, DFF, 1, 1, 0, 128 * (r / nbk), 256 * (r % nbk), WGU8_SCALE}; return; } r -= NEXP * WT_GU;
        if (r < NEXP * WT_GU) { const int e = r / WT_GU; r -= e * WT_GU; nbk = 2; t = WTile{w_u + (size_t)e * D * DFF, ws + WS_WGU + (size_t)e * 1024 * D, D, DFF, 1, 2, 0, 128 * (r / nbk), 256 * (r % nbk), WGU8_SCALE}; return; } r -= NEXP * WT_GU;
        { const int e = r / WT_DN; r -= e * WT_DN; nbk = 8; t = WTile{w_d + (size_t)e * DFF * D, ws + WS_WD + (size_t)e * D * DFF, DFF, D, 1, 0, 0, 128 * (r / nbk), 256 * (r % nbk), WD8_SCALE}; }
    };
    int ti = tb + wg; if (ti >= te) return;
    WTile cur, nxt; f32x4 x[16]; decode(ti, cur); conv_tile_load(cur, x, C.wave, C.lane);
    for (;;) {
        conv_tile_stage(cur, x, L, C.wave, C.lane);
        const int tn = ti + nwg; const bool has = tn < te;
        if (has) { decode(tn, nxt); conv_tile_load(nxt, x, C.wave, C.lane); }
        __syncthreads();
        conv_tile_store(cur, L, C.wave, C.lane);
        __syncthreads();
        if (!has) break;
        cur = nxt; ti = tn;
    }
}
__device__ __forceinline__ void phase_prep(Ctx& C, const CAS Args* A_, int layer, bool late, int gw, int NGW) {
    if (late) { conv_tiles(C, A_, layer, WT_EARLY, WT_ALL + (layer + 1 < NLAYER ? WT_EARLY : 0), C.vcu, C.G); return; }
    if (!LATE_PCT) conv_tiles(C, A_, layer, 0, WT_ALL, C.vcu, C.G);
    else if (layer == 0) conv_tiles(C, A_, layer, 0, WT_EARLY, C.vcu, C.G);
    GAS bf16* H = (GAS bf16*)(C.ws + WS_H); GAS bf16* MemH = (GAS bf16*)(C.ws + WS_MEMH);
    if (layer == 0) { const GAS float* xin = (const GAS float*)A_->in[0];
        for (int m = gw; m < T; m += NGW) rms_row_to_bf16(xin + (size_t)m * D, ((const GAS float*)A_->in[2]) + layer * D, H + (size_t)m * D, C.lane, (GAS unsigned char*)(C.ws + WS_H8) + (size_t)m * D); }
    else { const GAS bf16* xb = (const GAS bf16*)(C.ws + WS_XB);
        for (int m = gw; m < T; m += NGW) rms_row_from_bf16(xb + (size_t)m * D, ((const GAS float*)A_->in[2]) + layer * D, H + (size_t)m * D, C.lane, (GAS unsigned char*)(C.ws + WS_H8) + (size_t)m * D); }
    for (int m = gw; m < MEMT; m += NGW) rms_row_to_bf16(((const GAS float*)A_->in[1]) + (size_t)m * D, ((const GAS float*)A_->in[3]) + layer * D, MemH + (size_t)m * D, C.lane);
}

typedef float f32x4_t __attribute__((ext_vector_type(4)));
__device__ __forceinline__ bf16x8 ld_lds16(const LAS bf16* p) { return *(const LAS bf16x8*)p; }
__device__ __forceinline__ bf16x8 ld_lds8x2(const LAS bf16* p0, const LAS bf16* p1) {
    const v2u a = *(const LAS v2u*)p0, b = *(const LAS v2u*)p1; v4u w; w.x = a.x; w.y = a.y; w.z = b.x; w.w = b.y; return __builtin_bit_cast(bf16x8, w);
}
__device__ __forceinline__ float quad_sum(float v, int lane) { v += shx(v, 16, lane); v += shx(v, 32, lane); return v; }
__device__ __forceinline__ float quad_max(float v, int lane) { v = fmaxf(v, shx(v, 16, lane)); v = fmaxf(v, shx(v, 32, lane)); return v; }
#define MFMA16(a, b, c) __builtin_amdgcn_mfma_f32_16x16x32_bf16((a), (b), (c), 0, 0, 0)
typedef short v4i16_t __attribute__((ext_vector_type(4)));
__device__ __forceinline__ bf16x8 ld_tr2(const LAS bf16* base, int pitch, int rowA, int rowB, int col0, int lane) {
    const int q = (lane & 15) >> 2, p = lane & 3;
    const v4i16_t a = __builtin_amdgcn_ds_read_tr16_b64_v4i16((LAS v4i16_t*)(base + (rowA + q) * pitch + col0 + 4 * p));
    const v4i16_t b = __builtin_amdgcn_ds_read_tr16_b64_v4i16((LAS v4i16_t*)(base + (rowB + q) * pitch + col0 + 4 * p));
    bf16x8 r; r[0] = a[0]; r[1] = a[1]; r[2] = a[2]; r[3] = a[3]; r[4] = b[0]; r[5] = b[1]; r[6] = b[2]; r[7] = b[3]; return r;
}

constexpr int VA_PITCH = 144;
struct ARaw { unsigned xv[16]; f32x2 gv; f32x4 wf[4][2]; v2u uu[8]; float bt; };
__device__ __forceinline__ void mixer_a_load(Ctx& C, const CAS Args* A_, int layer, int unit, ARaw& R) {
    const int g = unit & 7, bn = unit >> 3;
    const GAS bf16* P1 = (const GAS bf16*)(C.ws + WS_P1);
    const GAS float* vgain = ((const GAS float*)A_->in[6]) + (layer * 8 + g) * 128; const GAS float* Wsp = ((const GAS float*)A_->in[7]) + (size_t)(layer * 8 + g) * 128 * 128; const GAS float* bsp = ((const GAS float*)A_->in[8]) + (layer * 8 + g) * 128;
    const int lane = C.lane, fr = lane & 15, fq = lane >> 4, w = C.wave, t = 16 * w + fr; const size_t row = (size_t)(bn * 128 + t);
#pragma unroll
    for (int i = 0; i < 16; ++i) R.xv[i] = *(const GAS unsigned*)(P1 + (size_t)(bn * 128 + 16 * w + i) * 2048 + 1024 + g * 128 + 2 * lane);
    R.gv = *(const GAS f32x2*)(vgain + 2 * lane);
#pragma unroll
    for (int ks = 0; ks < 4; ++ks) { R.wf[ks][0] = *(const GAS f32x4*)(Wsp + t * 128 + 32 * ks + 8 * fq); R.wf[ks][1] = *(const GAS f32x4*)(Wsp + t * 128 + 32 * ks + 8 * fq + 4); }
#pragma unroll
    for (int ct = 0; ct < 8; ++ct) R.uu[ct] = *(const GAS v2u*)(P1 + row * 2048 + g * 128 + 16 * ct + 4 * fq);
    R.bt = bsp[t];
}
__device__ __forceinline__ void mixer_a_compute(Ctx& C, int unit, const ARaw& R) {
    const int g = unit & 7, bn = unit >> 3;
    GAS bf16* Y = (GAS bf16*)(C.ws + WS_Y);
    LAS bf16* Vn = (LAS bf16*)C.lds;
    const int lane = C.lane, fr = lane & 15, fq = lane >> 4, w = C.wave;
    const int t = 16 * w + fr;
    const size_t row = (size_t)(bn * 128 + t);
    __syncthreads();
#pragma unroll
    for (int i = 0; i < 16; ++i) { const float a = bflo(R.xv[i]), b = bfhi(R.xv[i]);
        const float rstd = 1.f / sqrtf(wave_sum(a * a + b * b, lane) * (1.f / 128) + EPS);
        *(LAS unsigned*)(Vn + (16 * w + i) * VA_PITCH + 2 * lane) = pk2(a * rstd * R.gv[0], b * rstd * R.gv[1]); }
    __syncthreads();
    f32x4 acc[8];
#pragma unroll
    for (int ct = 0; ct < 8; ++ct) acc[ct] = (f32x4){C.zf, C.zf, C.zf, C.zf};
#pragma unroll
    for (int ks = 0; ks < 4; ++ks) {
        const int s0 = 32 * ks + 8 * fq; const f32x4 w0 = R.wf[ks][0], w1 = R.wf[ks][1];
        v4u wb; wb.x = pk2(s0 + 0 <= t ? w0[0] : 0.f, s0 + 1 <= t ? w0[1] : 0.f); wb.y = pk2(s0 + 2 <= t ? w0[2] : 0.f, s0 + 3 <= t ? w0[3] : 0.f);
        wb.z = pk2(s0 + 4 <= t ? w1[0] : 0.f, s0 + 5 <= t ? w1[1] : 0.f); wb.w = pk2(s0 + 6 <= t ? w1[2] : 0.f, s0 + 7 <= t ? w1[3] : 0.f);
        const bf16x8 bfrag = __builtin_bit_cast(bf16x8, wb);
        if (32 * ks <= 16 * w + 15) {
#pragma unroll
            for (int ct = 0; ct < 8; ++ct) acc[ct] = MFMA16(ld_tr2(Vn, VA_PITCH, 32 * ks + 8 * fq, 32 * ks + 8 * fq + 4, 16 * ct, lane), bfrag, acc[ct]); }
    }
    const float bt = R.bt;
#pragma unroll
    for (int ct = 0; ct < 8; ++ct) {
        const int c = 16 * ct + 4 * fq;
        v2u o; o.x = pk2(bflo(R.uu[ct].x) * (acc[ct][0] + bt), bfhi(R.uu[ct].x) * (acc[ct][1] + bt)); o.y = pk2(bflo(R.uu[ct].y) * (acc[ct][2] + bt), bfhi(R.uu[ct].y) * (acc[ct][3] + bt));
        *(GAS v2u*)(Y + row * 3072 + g * 128 + c) = o;
    }
}
constexpr int KB_PITCH = 72, VB_PITCH = 80;
struct BRaw { v4u qx[4][2]; v2u kx[8], vx[8]; float sink4[4]; };
struct BGain { f32x4 gq0[2], gq1[2], kg4; };
__device__ __forceinline__ void mixer_b_load(Ctx& C, const CAS Args* A_, int layer, int unit, BRaw& R) {
    const int hk = unit & 3, bn = unit >> 2, n = bn & 31;
    const GAS bf16* P2 = (const GAS bf16*)(C.ws + WS_P2);
    const GAS float* sinks = ((const GAS float*)A_->in[11]) + layer * 16;
    const int lane = C.lane, fr = lane & 15, fq = lane >> 4, w = C.wave, rg = lane >> 4, dc = lane & 15;
    const size_t row = (size_t)bn * 128 + 16 * w + fr;
#pragma unroll
    for (int qh = 0; qh < 4; ++qh)
#pragma unroll
        for (int ks = 0; ks < 2; ++ks) R.qx[qh][ks] = *(const GAS v4u*)(P2 + row * 1536 + (hk * 4 + qh) * 64 + 32 * ks + 8 * fq);
#pragma unroll
    for (int it = 0; it < 8; ++it) { const int kj = 32 * w + 4 * it + rg; const bool ok = (n > 0 || kj >= 128);
        const size_t r2 = ok ? (size_t)bn * 128 - 128 + kj : (size_t)bn * 128;
        R.kx[it] = *(const GAS v2u*)(P2 + r2 * 1536 + 1024 + hk * 64 + 4 * dc); R.vx[it] = *(const GAS v2u*)(P2 + r2 * 1536 + 1280 + hk * 64 + 4 * dc);
        if (!ok) { R.kx[it] = (v2u){0u, 0u}; R.vx[it] = (v2u){0u, 0u}; } }
#pragma unroll
    for (int qh = 0; qh < 4; ++qh) R.sink4[qh] = sinks[hk * 4 + qh];
}
__device__ __forceinline__ void mixer_b_gains(Ctx& C, const CAS Args* A_, int layer, BGain& G) {
    const GAS float* qg = ((const GAS float*)A_->in[9]) + layer * 64; const GAS float* kg = ((const GAS float*)A_->in[10]) + layer * 64; const int fq = C.lane >> 4, dc = C.lane & 15;
#pragma unroll
    for (int ks = 0; ks < 2; ++ks) { G.gq0[ks] = *(const GAS f32x4*)(qg + 32 * ks + 8 * fq); G.gq1[ks] = *(const GAS f32x4*)(qg + 32 * ks + 8 * fq + 4); }
    G.kg4 = *(const GAS f32x4*)(kg + 4 * dc);
}
__device__ __forceinline__ void mixer_b_compute(Ctx& C, const CAS Args* A_, int layer, int unit, BRaw& R, const BGain& G, bool has_next, int next_unit) {
    const int hk = unit & 3, bn = unit >> 2, n = bn & 31;
    GAS bf16* Y = (GAS bf16*)(C.ws + WS_Y);
    LAS bf16* Ks = (LAS bf16*)C.lds;
    LAS bf16* Vs = Ks + 256 * KB_PITCH;
    const int lane = C.lane, fr = lane & 15, fq = lane >> 4, w = C.wave;
    const int qi = 16 * w + fr; const size_t row = (size_t)bn * 128 + qi;
    bf16x8 qfa[4][2]; float sink4[4];
    {
        float gq[2][8];
#pragma unroll
        for (int ks = 0; ks < 2; ++ks)
#pragma unroll
            for (int e = 0; e < 4; ++e) { gq[ks][e] = G.gq0[ks][e]; gq[ks][4 + e] = G.gq1[ks][e]; }
#pragma unroll
        for (int qh = 0; qh < 4; ++qh) sink4[qh] = R.sink4[qh];
#pragma unroll
        for (int qh = 0; qh < 4; ++qh) {
            float qv[2][8]; float ss = 0.f;
#pragma unroll
            for (int ks = 0; ks < 2; ++ks) { const v4u x = R.qx[qh][ks];
                qv[ks][0] = bflo(x.x); qv[ks][1] = bfhi(x.x); qv[ks][2] = bflo(x.y); qv[ks][3] = bfhi(x.y); qv[ks][4] = bflo(x.z); qv[ks][5] = bfhi(x.z); qv[ks][6] = bflo(x.w); qv[ks][7] = bfhi(x.w);
#pragma unroll
                for (int e = 0; e < 8; ++e) ss += qv[ks][e] * qv[ks][e]; }
            const float qr = 0.125f / sqrtf(quad_sum(ss, lane) * (1.f / 64) + EPS);
#pragma unroll
            for (int ks = 0; ks < 2; ++ks) { v4u p;
                p.x = pk2(qv[ks][0] * qr * gq[ks][0], qv[ks][1] * qr * gq[ks][1]); p.y = pk2(qv[ks][2] * qr * gq[ks][2], qv[ks][3] * qr * gq[ks][3]);
                p.z = pk2(qv[ks][4] * qr * gq[ks][4], qv[ks][5] * qr * gq[ks][5]); p.w = pk2(qv[ks][6] * qr * gq[ks][6], qv[ks][7] * qr * gq[ks][7]); qfa[qh][ks] = __builtin_bit_cast(bf16x8, p); }
        }
    }
    __syncthreads();
    {
        const int rg = lane >> 4, dc = lane & 15;
        const f32x4 kg4 = G.kg4;
#pragma unroll
        for (int it = 0; it < 8; ++it) { const int kj = 32 * w + 4 * it + rg;
            const float a0 = bflo(R.kx[it].x), a1 = bfhi(R.kx[it].x), a2 = bflo(R.kx[it].y), a3 = bfhi(R.kx[it].y);
            float ss = (a0 * a0 + a1 * a1) + (a2 * a2 + a3 * a3);
            ss += shx(ss, 1, lane); ss += shx(ss, 2, lane); ss += shx(ss, 4, lane); ss += shx(ss, 8, lane);
            const float rstd = 1.f / sqrtf(ss * (1.f / 64) + EPS);
            v2u o; o.x = pk2(a0 * rstd * kg4[0], a1 * rstd * kg4[1]); o.y = pk2(a2 * rstd * kg4[2], a3 * rstd * kg4[3]);
            *(LAS v2u*)(Ks + kj * KB_PITCH + 4 * dc) = o; *(LAS v2u*)(Vs + kj * VB_PITCH + 4 * dc) = R.vx[it]; }
    }
    __syncthreads();
    if (has_next) mixer_b_load(C, A_, layer, next_unit, R);
#pragma unroll
    for (int qh = 0; qh < 4; ++qh) {
        const int h = hk * 4 + qh;
        int ldo = 0; asm volatile("" : "+v"(ldo));
        const LAS bf16* Ksl = Ks + ldo; const LAS bf16* Vsl = Vs + ldo;
        bf16x8 qf[2]; qf[0] = qfa[qh][0]; qf[1] = qfa[qh][1];
        f32x4 sc[9];
#pragma unroll
        for (int kt = 0; kt < 9; ++kt) { sc[kt] = (f32x4){C.zf, C.zf, C.zf, C.zf};
#pragma unroll
            for (int ks = 0; ks < 2; ++ks) sc[kt] = MFMA16(ld_lds16(Ksl + (16 * (w + kt) + fr) * KB_PITCH + 32 * ks + 8 * fq), qf[ks], sc[kt]); }
        const float sink = sink4[qh]; float mx = sink;
#pragma unroll
        for (int kt = 0; kt < 9; ++kt)
#pragma unroll
            for (int r = 0; r < 4; ++r) { const int kj = 16 * (w + kt) + 4 * fq + r; const bool ok = (kj > qi) && (kj <= qi + 128) && (n > 0 || kj >= 128);
                sc[kt][r] = ok ? sc[kt][r] : -3.0e38f; mx = fmaxf(mx, sc[kt][r]); }
        mx = quad_max(mx, lane); float l = 0.f;
#pragma unroll
        for (int kt = 0; kt < 9; ++kt)
#pragma unroll
            for (int r = 0; r < 4; ++r) { const float p = (sc[kt][r] > -1.0e38f) ? __expf(sc[kt][r] - mx) : 0.f; sc[kt][r] = p; l += p; }
        l = quad_sum(l, lane) + __expf(sink - mx);
        const float inv = 1.f / l;
        f32x4 oc[4];
#pragma unroll
        for (int dt = 0; dt < 4; ++dt) oc[dt] = (f32x4){C.zf, C.zf, C.zf, C.zf};
#pragma unroll
        for (int pr = 0; pr < 5; ++pr) {
            const int t0 = w + 2 * pr, t1r = w + 2 * pr + 1; const bool has1 = (2 * pr + 1) < 9; const int t1 = t1r > 15 ? 15 : t1r;
            v4u pb; pb.x = pk2(sc[2 * pr][0], sc[2 * pr][1]); pb.y = pk2(sc[2 * pr][2], sc[2 * pr][3]);
            if (has1) { pb.z = pk2(sc[has1 ? 2 * pr + 1 : 0][0], sc[has1 ? 2 * pr + 1 : 0][1]); pb.w = pk2(sc[has1 ? 2 * pr + 1 : 0][2], sc[has1 ? 2 * pr + 1 : 0][3]); } else { pb.z = 0u; pb.w = 0u; }
            const bf16x8 pfrag = __builtin_bit_cast(bf16x8, pb);
#pragma unroll
            for (int dt = 0; dt < 4; ++dt) oc[dt] = MFMA16(ld_tr2(Vsl, VB_PITCH, 16 * t0 + 4 * fq, 16 * t1 + 4 * fq, 16 * dt, lane), pfrag, oc[dt]);
        }
#pragma unroll
        for (int dt = 0; dt < 4; ++dt) { const float i8 = inv * YBC8_SCALE; unsigned ro = (unsigned)row * 6144u + (unsigned)(2048 + h * 64 + 4 * fq); asm volatile("" : "+v"(ro));
            *(GAS unsigned*)((GAS unsigned char*)Y + ro + 16 * dt) = pk4_fp8(oc[dt][0] * i8, oc[dt][1] * i8, oc[dt][2] * i8, oc[dt][3] * i8); }
    }
}
constexpr int KC_PITCH = 264, VC_PITCH = 272;
struct CRaw { v2u kx[16]; v4u qx[8]; };
__device__ __forceinline__ void mixer_c_load(Ctx& C, int unit, CRaw& R) {
    const int h = unit & 3, qt = unit >> 2, b = qt >> 5;
    const GAS bf16* P3 = (const GAS bf16*)(C.ws + WS_P3); const GAS bf16* KVM = (const GAS bf16*)(C.ws + WS_KVM);
    const int lane = C.lane, fr = lane & 15, fq = lane >> 4, w = C.wave; const size_t row = (size_t)qt * 128 + 16 * w + fr;
#pragma unroll
    for (int i = 0; i < 16; ++i) R.kx[i] = *(const GAS v2u*)(KVM + (size_t)(b * 256 + 32 * w + i) * 2048 + h * 256 + 4 * lane);
#pragma unroll
    for (int ks = 0; ks < 8; ++ks) R.qx[ks] = *(const GAS v4u*)(P3 + row * 1024 + h * 256 + 32 * ks + 8 * fq);
}
__device__ __forceinline__ void mixer_c_compute(Ctx& C, int unit, CRaw& R, f32x4 cg4, bool has_next, int next_unit) {
    const int h = unit & 3, qt = unit >> 2, b = qt >> 5;
    const GAS bf16* KVM = (const GAS bf16*)(C.ws + WS_KVM); GAS bf16* Y = (GAS bf16*)(C.ws + WS_Y);
    LAS bf16* KV = (LAS bf16*)C.lds;
    const int lane = C.lane, fr = lane & 15, fq = lane >> 4, w = C.wave;
    v2u kx2[16];
#pragma unroll
    for (int i = 0; i < 16; ++i) kx2[i] = *(const GAS v2u*)(KVM + (size_t)(b * 256 + 32 * w + 16 + i) * 2048 + h * 256 + 4 * lane);
    __syncthreads();
#pragma unroll
    for (int i = 0; i < 32; ++i) {
        const v2u kxi = i < 16 ? R.kx[i & 15] : kx2[i & 15];
        const float a0 = bflo(kxi.x), a1 = bfhi(kxi.x), a2 = bflo(kxi.y), a3 = bfhi(kxi.y);
        const float rstd = 1.f / sqrtf(wave_sum(a0 * a0 + a1 * a1 + a2 * a2 + a3 * a3, lane) * (1.f / 256) + EPS);
        v2u o; o.x = pk2(a0 * rstd * cg4[0], a1 * rstd * cg4[1]); o.y = pk2(a2 * rstd * cg4[2], a3 * rstd * cg4[3]);
        *(LAS v2u*)(KV + (32 * w + i) * KC_PITCH + 4 * lane) = o; if ((i & 7) == 7) asm volatile("" ::: "memory"); }
    __syncthreads();
    const size_t row = (size_t)qt * 128 + 16 * w + fr;
    bf16x8 pf[8];
    {
        bf16x8 qf[8];
        {
            float ss = 0.f;
#pragma unroll
            for (int ks = 0; ks < 8; ++ks) { const v4u x = R.qx[ks];
                const float e0 = bflo(x.x), e1 = bfhi(x.x), e2 = bflo(x.y), e3 = bfhi(x.y), e4 = bflo(x.z), e5 = bfhi(x.z), e6 = bflo(x.w), e7 = bfhi(x.w);
                ss += (e0 * e0 + e1 * e1) + (e2 * e2 + e3 * e3) + (e4 * e4 + e5 * e5) + (e6 * e6 + e7 * e7); }
            const float qr = 0.0625f / sqrtf(quad_sum(ss, lane) * (1.f / 256) + EPS);
#pragma unroll
            for (int ks = 0; ks < 8; ++ks) { const v4u x = R.qx[ks]; v4u p;
                p.x = pk2(bflo(x.x) * qr, bfhi(x.x) * qr); p.y = pk2(bflo(x.y) * qr, bfhi(x.y) * qr); p.z = pk2(bflo(x.z) * qr, bfhi(x.z) * qr); p.w = pk2(bflo(x.w) * qr, bfhi(x.w) * qr);
                qf[ks] = __builtin_bit_cast(bf16x8, p); }
        }
        f32x4 sc[16];
#pragma unroll
        for (int mt = 0; mt < 16; ++mt) { sc[mt] = (f32x4){C.zf, C.zf, C.zf, C.zf};
#pragma unroll
            for (int ks = 0; ks < 8; ++ks) sc[mt] = MFMA16(ld_lds16(KV + (16 * mt + fr) * KC_PITCH + 32 * ks + 8 * fq), qf[ks], sc[mt]);
            asm volatile("" ::: "memory"); }
        float mx = -3.0e38f;
#pragma unroll
        for (int mt = 0; mt < 16; ++mt) mx = fmaxf(fmaxf(mx, fmaxf(sc[mt][0], sc[mt][1])), fmaxf(sc[mt][2], sc[mt][3]));
        mx = quad_max(mx, lane); float l = 0.f;
#pragma unroll
        for (int mt = 0; mt < 16; ++mt)
#pragma unroll
            for (int r = 0; r < 4; ++r) { sc[mt][r] = __expf(sc[mt][r] - mx); l += sc[mt][r]; }
        const float inv = 1.f / quad_sum(l, lane);
#pragma unroll
        for (int pr = 0; pr < 8; ++pr) { v4u pb; pb.x = pk2(sc[2 * pr][0] * inv, sc[2 * pr][1] * inv); pb.y = pk2(sc[2 * pr][2] * inv, sc[2 * pr][3] * inv);
            pb.z = pk2(sc[2 * pr + 1][0] * inv, sc[2 * pr + 1][1] * inv); pb.w = pk2(sc[2 * pr + 1][2] * inv, sc[2 * pr + 1][3] * inv); pf[pr] = __builtin_bit_cast(bf16x8, pb); }
    }
    v2u vx[16], vx2[16];
#pragma unroll
    for (int i = 0; i < 16; ++i) { vx[i] = *(const GAS v2u*)(KVM + (size_t)(b * 256 + 32 * w + i) * 2048 + 1024 + h * 256 + 4 * lane); vx2[i] = *(const GAS v2u*)(KVM + (size_t)(b * 256 + 32 * w + 16 + i) * 2048 + 1024 + h * 256 + 4 * lane); }
    __syncthreads();
#pragma unroll
    for (int i = 0; i < 16; ++i) *(LAS v2u*)(KV + (32 * w + i) * VC_PITCH + 4 * lane) = vx[i];
#pragma unroll
    for (int i = 0; i < 16; ++i) *(LAS v2u*)(KV + (32 * w + 16 + i) * VC_PITCH + 4 * lane) = vx2[i];
    __syncthreads();
    if (has_next) mixer_c_load(C, next_unit, R);
#pragma unroll 4
    for (int dt = 0; dt < 16; ++dt) {
        f32x4 oc = (f32x4){C.zf, C.zf, C.zf, C.zf};
#pragma unroll
        for (int pr = 0; pr < 8; ++pr) oc = MFMA16(ld_tr2(KV, VC_PITCH, 32 * pr + 4 * fq, 32 * pr + 16 + 4 * fq, 16 * dt, lane), pf[pr], oc);
        asm volatile("" ::: "memory");
        unsigned ro = (unsigned)row * 6144u + (unsigned)(3072 + h * 256 + 4 * fq); asm volatile("" : "+v"(ro));
        *(GAS unsigned*)((GAS unsigned char*)Y + ro + 16 * dt) = pk4_fp8(oc[0] * YBC8_SCALE, oc[1] * YBC8_SCALE, oc[2] * YBC8_SCALE, oc[3] * YBC8_SCALE);
    }
}
__device__ __forceinline__ void phase_mix(Ctx& C, const CAS Args* A_, int layer, int conv_slot) {
    constexpr int NA = NB * 32 * 8, NBU = NB * 32 * 4, NC = (T / 128) * 4;
#ifndef MIXSEL
#define MIXSEL 7
#endif
#ifndef MIXREP
#define MIXREP 0
#endif
    if (conv_slot == 0) { __syncthreads(); phase_prep(C, A_, layer, true, C.vcu * NWAVES + C.wave, C.G * NWAVES); __syncthreads(); relaunder(C); asm volatile("" : "+s"(A_)); }
    for (int rp = 0; rp < ((MIXREP & 1) ? 2 : 1); ++rp) {
        int u = C.vcu; ARaw R0, R1; if (u < NA) mixer_a_load(C, A_, layer, u, R0);
        while (u < NA) { const int un = u + C.G; if (un < NA) mixer_a_load(C, A_, layer, un, R1); mixer_a_compute(C, u, R0); R0 = R1; u = un; } }
    if (conv_slot == 1) { __syncthreads(); phase_prep(C, A_, layer, true, C.vcu * NWAVES + C.wave, C.G * NWAVES); __syncthreads(); relaunder(C); asm volatile("" : "+s"(A_)); }
    for (int rp = 0; rp < ((MIXREP & 2) ? 2 : 1); ++rp) {
        int u = C.vcu; BRaw R0; BGain BG; mixer_b_gains(C, A_, layer, BG); if (u < NBU) mixer_b_load(C, A_, layer, u, R0);
        while (u < NBU) { const int un = u + C.G; mixer_b_compute(C, A_, layer, u, R0, BG, un < NBU, un); u = un; } }
    if (conv_slot == 2) { __syncthreads(); phase_prep(C, A_, layer, true, C.vcu * NWAVES + C.wave, C.G * NWAVES); __syncthreads(); relaunder(C); asm volatile("" : "+s"(A_)); }
    for (int rp = 0; rp < ((MIXREP & 4) ? 2 : 1); ++rp) {
        const GAS float* qg = ((const GAS float*)A_->in[12]) + layer * 256; const GAS float* kg = ((const GAS float*)A_->in[13]) + layer * 256;
        const f32x4 cg4 = *(const GAS f32x4*)(kg + 4 * C.lane) * *(const GAS f32x4*)(qg + 4 * C.lane);
        int u = C.vcu; CRaw R0; if (u < NC) mixer_c_load(C, u, R0);
        while (u < NC) { const int un = u + C.G; mixer_c_compute(C, u, R0, cg4, un < NC, un); u = un; } }
    __syncthreads();
}

__device__ __forceinline__ void phase_route(Ctx& C, const CAS Args* A_, int layer) {
    const GAS float* gain = ((const GAS float*)A_->in[4]) + layer * D; const GAS float* wrg = ((const GAS float*)A_->in[17]) + (size_t)layer * D * 4; const GAS float* brg = ((const GAS float*)A_->in[18]) + layer * 4;
    const GAS float* wre = ((const GAS float*)A_->in[19]) + (size_t)layer * D * 16; const GAS float* bre = ((const GAS float*)A_->in[20]) + layer * 16;
    GAS bf16* H = (GAS bf16*)(C.ws + WS_H); GAS int* perm2 = (GAS int*)(C.ws + WS_PERM2); GAS float* roww2 = (GAS float*)(C.ws + WS_ROWW2);
    GAS unsigned* cnt = (GAS unsigned*)C.ctl + CW_CNT + layer * 32;
    LAS float* part = (LAS float*)C.lds;
    LAS float* rs = part + 16 * 64 * 24;
    const int lane = C.lane, w = C.wave, kq = lane >> 4, j = lane & 15;
    for (int blk = C.vcu; blk < T / 64; blk += C.G) {
        const int t0 = blk * 64;
        __syncthreads();
#pragma unroll 1
        for (int hf = 0; hf < 2; ++hf) {
    const int kbase = 256 * w + 128 * hf;
    float Be[4][8], Bg[4][8]; f32x4 gs[4][2];
    const GAS f32x4* gp4 = (const GAS f32x4*)(gain + kbase + 8 * kq); const GAS float* wep1 = wre + (size_t)(kbase + 8 * kq) * 16 + j; const GAS float* wgp1 = wrg + (size_t)(kbase + 8 * kq) * 4 + (j & 3);
#pragma unroll
    for (int s = 0; s < 4; ++s) { const f32x4 g4a = gp4[0], g4b = gp4[1]; gs[s][0] = g4a; gs[s][1] = g4b;
#pragma unroll
        for (int e = 0; e < 4; ++e) { Be[s][e] = wep1[e * 16] * g4a[e]; Bg[s][e] = wgp1[e * 4] * g4a[e]; Be[s][4 + e] = wep1[(4 + e) * 16] * g4b[e]; Bg[s][4 + e] = wgp1[(4 + e) * 4] * g4b[e]; }
        gp4 += 8; wep1 += 512; wgp1 += 128; asm volatile("" : "+v"(gp4), "+v"(wep1), "+v"(wgp1)); }
    if (j >= 4) {
#pragma unroll
        for (int s = 0; s < 4; ++s)
#pragma unroll
            for (int e = 0; e < 8; ++e) Bg[s][e] = 0.f; }
#pragma unroll 1
        for (int tt = 0; tt < 4; ++tt) {
            const GAS bf16* xp = (const GAS bf16*)(C.ws + WS_XB) + (size_t)(t0 + 16 * tt + j) * D + kbase + 8 * kq; GAS unsigned char* hp = (GAS unsigned char*)(C.ws + WS_H8) + (size_t)(t0 + 16 * tt + j) * D + kbase + 8 * kq;
            f32x4 ae = (f32x4){C.zf, C.zf, C.zf, C.zf}, ag = (f32x4){C.zf, C.zf, C.zf, C.zf}; float ssq = 0.f;
            {
                v4u xr[4];
#pragma unroll
                for (int s = 0; s < 4; ++s) xr[s] = *(const GAS v4u*)(xp + 32 * s);
#pragma unroll
                for (int s = 0; s < 4; ++s) { const f32x4 xa = (f32x4){bflo(xr[s].x), bfhi(xr[s].x), bflo(xr[s].y), bfhi(xr[s].y)}, xb4 = (f32x4){bflo(xr[s].z), bfhi(xr[s].z), bflo(xr[s].w), bfhi(xr[s].w)};
                    ssq += ((xa[0] * xa[0] + xa[1] * xa[1]) + (xa[2] * xa[2] + xa[3] * xa[3])) + ((xb4[0] * xb4[0] + xb4[1] * xb4[1]) + (xb4[2] * xb4[2] + xb4[3] * xb4[3]));
                    const f32x4 ha = xa * gs[s][0], hb = xb4 * gs[s][1];
                    if (MOE1_FP8) *(GAS v2u*)(hp + 32 * s) = (v2u){pk4_fp8(ha[0], ha[1], ha[2], ha[3]), pk4_fp8(hb[0], hb[1], hb[2], hb[3])};
                    else *(GAS v4u*)(H + (size_t)(t0 + 16 * tt + j) * D + kbase + 8 * kq + 32 * s) = pack8(ha, hb);
#pragma unroll
                    for (int e = 0; e < 4; ++e) { ae = __builtin_amdgcn_mfma_f32_16x16x4f32(xa[e], Be[s][e], ae, 0, 0, 0); ag = __builtin_amdgcn_mfma_f32_16x16x4f32(xa[e], Bg[s][e], ag, 0, 0, 0); }
#pragma unroll
                    for (int e = 0; e < 4; ++e) { ae = __builtin_amdgcn_mfma_f32_16x16x4f32(xb4[e], Be[s][4 + e], ae, 0, 0, 0); ag = __builtin_amdgcn_mfma_f32_16x16x4f32(xb4[e], Bg[s][4 + e], ag, 0, 0, 0); } }
            }
            ssq += shx(ssq, 16, lane); ssq += shx(ssq, 32, lane);
            LAS float* pw = part + ((2 * w + hf) * 64 + 16 * tt) * 24;
#pragma unroll
            for (int r = 0; r < 4; ++r) { pw[(4 * kq + r) * 24 + j] = ae[r]; if (j < 4) pw[(4 * kq + r) * 24 + 16 + j] = ag[r]; }
            if (kq == 0) pw[j * 24 + 20] = ssq;
        }
        }
        __syncthreads();
        if (C.tid < 64) {
            const int t = t0 + C.tid;
            float lg[4], le[16]; float ssq = 0.f;
#pragma unroll
            for (int c = 0; c < 4; ++c) lg[c] = 0.f;
#pragma unroll
            for (int e = 0; e < 16; ++e) le[e] = 0.f;
#pragma unroll
            for (int ww = 0; ww < 16; ++ww) { const LAS float* p = part + (ww * 64 + C.tid) * 24;
#pragma unroll
                for (int e = 0; e < 16; ++e) le[e] += p[e];
#pragma unroll
                for (int c = 0; c < 4; ++c) lg[c] += p[16 + c];
                ssq += p[20]; }
            const float rstd = 1.f / sqrtf(ssq * (1.f / D) + EPS);
#pragma unroll
            for (int c = 0; c < 4; ++c) lg[c] = lg[c] * rstd + brg[c];
#pragma unroll
            for (int e = 0; e < 16; ++e) le[e] = le[e] * rstd + bre[e];
            int g = 0; float gm = lg[0];
#pragma unroll
            for (int c = 1; c < 4; ++c) if (lg[c] > gm) { gm = lg[c]; g = c; }
            float den = 0.f;
#pragma unroll
            for (int c = 0; c < 4; ++c) den += __expf(lg[c] - gm);
            const float pg = 1.f / den;
            float el[4] = {0.f, 0.f, 0.f, 0.f};
#pragma unroll
            for (int c = 0; c < 4; ++c)
#pragma unroll
                for (int jj = 0; jj < 4; ++jj) el[jj] = (c == g) ? le[4 * c + jj] : el[jj];
            int i1 = 0; float v1 = el[0];
#pragma unroll
            for (int jj = 1; jj < 4; ++jj) if (el[jj] > v1) { v1 = el[jj]; i1 = jj; }
            int i2 = (i1 == 0) ? 1 : 0; float v2 = el[i2];
#pragma unroll
            for (int jj = 0; jj < 4; ++jj) if (jj != i1 && el[jj] > v2) { v2 = el[jj]; i2 = jj; }
            const float e2 = __expf(v2 - v1); const float w1 = pg / (1.f + e2), w2 = pg * e2 / (1.f + e2);
            const int lo = i1 < i2 ? i1 : i2, hi = i1 < i2 ? i2 : i1; const float wlo = i1 < i2 ? w1 : w2, whi = i1 < i2 ? w2 : w1;
            const int pi = lo == 0 ? hi - 1 : (lo == 1 ? hi + 1 : 5);
            const int bucket = g * 6 + pi;
            int rank = 0, nsame = 1, leader = C.tid;
#pragma unroll 1
            for (int b = 0; b < NBUCKET; ++b) { const unsigned long long m = __builtin_amdgcn_ballot_w64(bucket == b);
                if (bucket == b) { rank = (int)__builtin_amdgcn_mbcnt_hi((unsigned)(m >> 32), __builtin_amdgcn_mbcnt_lo((unsigned)m, 0u)); nsame = __builtin_popcountll(m); leader = __builtin_ctzll(m); } }
            unsigned base = 0u; if (rank == 0) base = __hip_atomic_fetch_add(cnt + bucket, (unsigned)nsame, RLX_AGENT);
            base = (unsigned)__builtin_amdgcn_ds_bpermute(leader << 2, (int)base);
            const unsigned pos = base + (unsigned)rank; const size_t slot = (size_t)bucket * T + pos;
            perm2[slot] = t; *(GAS f32x4*)(roww2 + 4 * slot) = (f32x4){wlo, whi, rstd, 0.f};
        }
    }
}
__device__ __forceinline__ void moe_tables(Ctx& C, int layer) {
    GAS unsigned* cnt = (GAS unsigned*)C.ctl + CW_CNT + layer * 32;
    __syncthreads();
    if (C.tid < NBUCKET) C.lw[LW_CNT + C.tid] = __hip_atomic_load(cnt + C.tid, RLX_AGENT);
    __syncthreads();
    if (C.tid == 0) { unsigned acc = 0; for (int b = 0; b < NBUCKET; ++b) { C.lw[LW_TSTART + b] = acc; acc += (C.lw[LW_CNT + b] + 255u) >> 8; } C.lw[LW_TSTART + NBUCKET] = acc; C.lw[LW_NT] = acc; }
    __syncthreads();
}
constexpr int PH_PER_LAYER = 9, N_PHASES = NLAYER * PH_PER_LAYER;
template <int PMASK> __global__ void __launch_bounds__(NTHR, 2) fwd(Args args) {
    extern __shared__ __attribute__((aligned(16))) unsigned char lds_raw[];
    const CAS Args* ap = (const CAS Args*)__builtin_amdgcn_kernarg_segment_ptr();
    Ctx C;
    C.lds = (LAS unsigned char*)lds_raw; C.lw = (volatile LAS unsigned*)(C.lds + LDS_CTL_OFF);
    C.out = (GAS float*)args.out; C.ws = (GAS unsigned char*)args.ws; C.ctl = (gu32*)(args.ws + WS_CTL);
    C.tid = threadIdx.x; C.lane = C.tid & 63; C.wave = __builtin_amdgcn_readfirstlane(C.tid >> 6);
    C.G = gridDim.x; C.bid = blockIdx.x; { const int bx = blockIdx.x; C.vcu = (C.G % 8 == 0) ? (bx % 8) * (C.G / 8) + bx / 8 : bx; }
    C.zf = 0.f;
    for (int u = C.tid; u < (LDS_BYTES - LDS_CTL_OFF) / 4; u += NTHR) C.lw[u] = 0u;
    __syncthreads();
#if MEGA
    XcdBarrier bar = xcd_barrier_post((unsigned*)(args.ws + WS_CTL) + CW_BAR, C.lw + LW_BAR);
#define GRID_BAR() do { XcdBarrier b2_ = bar; asm volatile("" : "+s"(b2_.bar)); xcd_barrier(b2_); } while (0)
#else
#define GRID_BAR() do {} while (0)
#endif
    const int lo = args.ph_lo, hi = args.ph_hi;
#define IN(k) (((PMASK >> ((k) % PH_PER_LAYER)) & 1) && lo <= (k) && (k) < hi)
#define SEAM(k) do { if (IN(k) && IN((k) + 1)) GRID_BAR(); relaunder(C); asm volatile("" : "+s"(ap)); } while (0)
    for (int layer = 0; layer < NLAYER; ++layer) {
        const int p0 = layer * PH_PER_LAYER;
        if (IN(p0 + 0)) { for (int rep = 0; rep < NREP(0); ++rep) phase_prep(C, ap, layer, false, C.vcu * NWAVES + C.wave, C.G * NWAVES); } SEAM(p0 + 0);
        if (IN(p0 + 1)) { const GAS char* ws = (const GAS char*)C.ws;
            SchedInProj S{ws + WS_H, ws + WS_WIN, ws + WS_MEMH, ws + WS_WMKV, C.G, C.bid, 0};
            EpiInProj E{(GAS bf16*)(C.ws + WS_P1), (GAS bf16*)(C.ws + WS_P2), (GAS bf16*)(C.ws + WS_P3), (GAS bf16*)(C.ws + WS_P4), (GAS bf16*)(C.ws + WS_KVM)};
            for (int rep = 0; rep < NREP(1); ++rep) gemm_run<1, EpiInProj, SchedInProj, 1>(C.lds, D * 2, D * 2, D / 64, S, E);
            __syncthreads();
            {
                EpiGate EG{(GAS unsigned char*)(C.ws + WS_P4), (GAS bf16*)(C.ws + WS_P2), (GAS bf16*)(C.ws + WS_P3)};
                const int rem1 = (64 * 8 + 4 * 8) % C.G;
                { SchedGate SG{ws + WS_H8, ws + WS_WG8, C.G, C.bid, rem1, 0, 1 << 20}; pg8::gemm_fast<EpiGate, SchedGate, 1, true>(C.lds, D, D, D / 128, SG, EG); }
            }
        } SEAM(p0 + 1);
        if (IN(p0 + 2)) { for (int rep = 0; rep < NREP(2); ++rep) phase_mix(C, ap, layer, LATE_PCT == 2 ? (C.bid % 3) : -1); } SEAM(p0 + 2);
        if (IN(p0 + 3)) { const GAS char* ws = (const GAS char*)C.ws;
            for (int rep = 0; rep < NREP(3); ++rep) {
                { SchedMerge S{ws + WS_Y, ws + WS_WBR, C.G, C.bid};
                  EpiMerge E{(const GAS unsigned char*)(C.ws + WS_P4), (GAS bf16*)(C.ws + WS_MF), (GAS bf16*)(C.ws + WS_H), 1.f / 255.f, layer == NLAYER - 1 ? 1 : 0};
                  gemm_run<3, EpiMerge, SchedMerge, 1>(C.lds, 6144, 1024 * 2, 1024 / 64, S, E); }
                __syncthreads();
                { SchedMerge8 S{ws + WS_Y, ws + WS_WBR, C.G, C.bid};
                  EpiMerge E{(const GAS unsigned char*)(C.ws + WS_P4), (GAS bf16*)(C.ws + WS_MF), (GAS bf16*)(C.ws + WS_H), 1.f / (255.f * YBC8_SCALE * WBR8_SCALE), layer == NLAYER - 1 ? 1 : 0};
                  pg8::gemm_fast<EpiMerge, SchedMerge8, 1, true>(C.lds, 6144, 1024, 1024 / 128, S, E); }
            }
        } SEAM(p0 + 3);
        if (IN(p0 + 4)) { const GAS char* ws = (const GAS char*)C.ws;
            if (layer == NLAYER - 1) {
                SchedOut S{ws + WS_H8, ws + WS_WOUT, C.G, C.bid, 1};
                EpiOut E{(const GAS float*)ap->in[0], (GAS bf16*)(C.ws + WS_XB), layer == 0 ? 1 : 0, 1.f / (MRG8_SCALE * WOUT8_SCALE)};
                pg8::gemm_fast<EpiOut, SchedOut, 1, true>(C.lds, D, D, D / 128, S, E);
            } else {
                SchedOut S{ws + WS_H, ws + WS_WOUT, C.G, C.bid, 2};
                EpiOut E{(const GAS float*)ap->in[0], (GAS bf16*)(C.ws + WS_XB), layer == 0 ? 1 : 0, 1.f};
                gemm_run<4, EpiOut, SchedOut, 1>(C.lds, D * 2, D * 2, D / 64, S, E);
            }
        } SEAM(p0 + 4);
        if (IN(p0 + 5)) { phase_route(C, ap, layer); } SEAM(p0 + 5);
        if (IN(p0 + 7)) { const GAS char* ws = (const GAS char*)C.ws;
            moe_tables(C, layer);
            SchedMoe1 S{ws + (MOE1_FP8 ? WS_H8 : WS_H), ws + WS_WGU, (const GAS int*)(C.ws + WS_PERM2), C.lw, C.G, C.vcu};
            EpiMoe1 E{(const GAS float*)(C.ws + WS_ROWW2), (GAS bf16*)(C.ws + WS_HID)};
            for (int rep = 0; rep < NREP(7); ++rep) { if constexpr (MOE1_FP8) pg8::gemm_fast<EpiMoe1, SchedMoe1, 1, true>(C.lds, D, D, D / 128, S, E); else pg8::gemm_fast<EpiMoe1, SchedMoe1, 1, false>(C.lds, D * 2, D * 2, D / 64, S, E); }
        } SEAM(p0 + 7);
        if (IN(p0 + 8)) { const GAS char* ws = (const GAS char*)C.ws;
            moe_tables(C, layer);
            SchedMoe2 S{ws + WS_HID, ws + WS_WD, C.lw, C.G, C.vcu};
            EpiMoe2 E{(const GAS int*)(C.ws + WS_PERM2), (GAS bf16*)(C.ws + WS_XB), C.out, layer == NLAYER - 1 ? 1 : 0};
            if constexpr (MOE2_FP8) pg8::gemm_fast<EpiMoe2, SchedMoe2, 2, true>(C.lds, 1024, DFF, DFF / 128, S, E);
            else pg8::gemm_fast<EpiMoe2, SchedMoe2, 2, false>(C.lds, 1024 * 2, DFF * 2, DFF / 64, S, E);
        } SEAM(p0 + 8);
    }
#undef IN
#undef SEAM
}

#ifdef TESTMASK
template __global__ void fwd<TESTMASK>(Args);
#else
extern "C" void kernel_launch(void* const* d_in, const int* in_sizes, int n_in, void* d_out, int out_size, void* d_ws, size_t ws_size, hipStream_t stream) {
    static int grid = 0;
    if (grid == 0) {
        if (n_in != 24 || in_sizes[0] != T * D || out_size != T * D || ws_size < WS_END) { fprintf(stderr, "kernel_launch: unexpected shapes / workspace (n_in %d, ws %zu < %zu)\n", n_in, ws_size, (size_t)WS_END); grid = -1; return; }
        int dev = 0, cus = 0, per_cu = 0;
        if (hipGetDevice(&dev) != hipSuccess || hipDeviceGetAttribute(&cus, hipDeviceAttributeMultiprocessorCount, dev) != hipSuccess) { grid = -1; return; }
#if MEGA
        const void* fns[1] = {(const void*)fwd<0x1FF>};
#else
        const void* fns[9] = {(const void*)fwd<1>, (const void*)fwd<2>, (const void*)fwd<4>, (const void*)fwd<8>, (const void*)fwd<16>, (const void*)fwd<32>, (const void*)fwd<64>, (const void*)fwd<128>, (const void*)fwd<256>};
#endif
        for (const void* fn : fns) {
            if (hipFuncSetAttribute(fn, hipFuncAttributeMaxDynamicSharedMemorySize, LDS_BYTES) != hipSuccess) { fprintf(stderr, "kernel_launch: hipFuncSetAttribute failed\n"); grid = -1; return; }
            if (hipOccupancyMaxActiveBlocksPerMultiprocessor(&per_cu, fn, NTHR, LDS_BYTES) != hipSuccess || per_cu < 1) fprintf(stderr, "kernel_launch: occupancy query reports %d\n", per_cu);
        }
        (void)hipGetLastError();
        grid = cus;
    }
    if (grid < 0) return;
    if (hipMemsetAsync((char*)d_ws + WS_CTL, 0, CTL_ZERO_BYTES, stream) != hipSuccess) return;
    Args a{};
    for (int i = 0; i < 24; ++i) a.in[i] = (const float*)d_in[i];
    a.out = (float*)d_out; a.ws = (unsigned char*)d_ws;
#if MEGA
    a.ph_lo = 0; a.ph_hi = N_PHASES;
    hipLaunchKernelGGL(fwd<0x1FF>, dim3(grid), dim3(NTHR), LDS_BYTES, stream, a);
#else
    for (int p = 0; p < N_PHASES; ++p) {
        a.ph_lo = p; a.ph_hi = p + 1; const int k = p % PH_PER_LAYER;
        switch (k) {
        case 0: hipLaunchKernelGGL(fwd<1>, dim3(grid), dim3(NTHR), LDS_BYTES, stream, a); break;
        case 1: hipLaunchKernelGGL(fwd<2>, dim3(grid), dim3(NTHR), LDS_BYTES, stream, a); break;
        case 2: hipLaunchKernelGGL(fwd<4>, dim3(grid), dim3(NTHR), LDS_BYTES, stream, a); break;
        case 3: hipLaunchKernelGGL(fwd<8>, dim3(grid), dim3(NTHR), LDS_BYTES, stream, a); break;
        case 4: hipLaunchKernelGGL(fwd<16>, dim3(grid), dim3(NTHR), LDS_BYTES, stream, a); break;
        case 5: hipLaunchKernelGGL(fwd<32>, dim3(grid), dim3(NTHR), LDS_BYTES, stream, a); break;
        case 6: hipLaunchKernelGGL(fwd<64>, dim3(grid), dim3(NTHR), LDS_BYTES, stream, a); break;
        case 7: hipLaunchKernelGGL(fwd<128>, dim3(grid), dim3(NTHR), LDS_BYTES, stream, a); break;
        default: hipLaunchKernelGGL(fwd<256>, dim3(grid), dim3(NTHR), LDS_BYTES, stream, a); break;
        }
    }
#endif
}
#endif
```

```cpp
#include <hip/hip_runtime.h>
#include <cstdio>
#include <cstdint>
#include <type_traits>

#ifndef MEGA
#define MEGA 1
#endif
#ifndef FAST_GEMM
#define FAST_GEMM 0
#endif

#define GAS __attribute__((address_space(1)))
#define CAS __attribute__((address_space(4)))
#define LAS __attribute__((address_space(3)))
typedef unsigned short bf16;
typedef unsigned v4u __attribute__((ext_vector_type(4)));
typedef unsigned v2u __attribute__((ext_vector_type(2)));
typedef float f32x4 __attribute__((ext_vector_type(4)));
typedef float f32x2 __attribute__((ext_vector_type(2)));
typedef short bf16x8 __attribute__((ext_vector_type(8)));
typedef GAS unsigned gu32;
#define RLX_AGENT __ATOMIC_RELAXED, __HIP_MEMORY_SCOPE_AGENT
#define LDS_WAIT() asm volatile("s_waitcnt lgkmcnt(0)" ::: "memory")
#define VM_WAIT() asm volatile("s_waitcnt vmcnt(0)" ::: "memory")

constexpr int NB = 4, SEQ = 4096, T = NB * SEQ, D = 2048, NIN = 10752, MEML = 256, MEMT = NB * MEML, NLAYER = 2;
constexpr int NEXP = 16, DFF = 512;
constexpr int NBUCKET = 24;
constexpr int TPAD = T + NBUCKET * 256;
constexpr float EPS = 1e-6f;
constexpr int NWAVES = 8, NTHR = 512;

constexpr size_t MiB = 1u << 20;
constexpr size_t WS_CTL = 0, CTL_ZERO_BYTES = 1 * MiB;
constexpr size_t WS_WIN = 4 * MiB;
constexpr size_t WS_WMKV = 46 * MiB;
constexpr size_t WS_WBR = 54 * MiB;
constexpr size_t WS_WOUT = 66 * MiB;
constexpr size_t WS_WGU = 74 * MiB;
constexpr size_t WS_WD = 138 * MiB;
constexpr size_t WS_H = 170 * MiB;
constexpr size_t WS_MEMH = 234 * MiB;
constexpr size_t WS_KVM = 238 * MiB;
constexpr size_t WS_P1 = 242 * MiB;
constexpr size_t WS_P2 = 306 * MiB;
constexpr size_t WS_P3 = 354 * MiB;
constexpr size_t WS_P4 = 386 * MiB;
constexpr size_t WS_XB = 482 * MiB;
constexpr size_t WS_Y = 578 * MiB;
constexpr size_t WS_H8 = 674 * MiB;
constexpr size_t WS_WG8 = 12 * MiB;
constexpr size_t WS_PERM2 = 706 * MiB;
constexpr size_t WS_ROWW2 = 708 * MiB;
constexpr size_t WS_END = 718 * MiB;
constexpr size_t WS_MF = WS_P1;
constexpr size_t WS_HID = WS_Y;
static_assert(WS_MF + (size_t)T * D * 2 <= WS_P2 && WS_HID + (size_t)TPAD * 1024 * 2 <= WS_H8, "overlays");
static_assert(WS_P4 + (size_t)T * 6144 <= WS_XB && WS_XB + (size_t)T * D * 2 <= WS_Y, "residual stream region");
static_assert(WS_PERM2 + (size_t)NBUCKET * T * 4 <= WS_ROWW2 && WS_ROWW2 + (size_t)NBUCKET * T * 16 <= WS_END, "bucket tables");
constexpr int CW_BAR = 4096;
constexpr int CW_CNT = 16384;

constexpr int LDS_BYTES = 147456;
constexpr int LDS_CTL_OFF = 146432;
constexpr int LW_BAR = 0;
constexpr int LW_TSTART = 16;
constexpr int LW_CNT = 48;
constexpr int LW_NT = 80;

__device__ __forceinline__ unsigned f2bf(float f) { unsigned u = __builtin_bit_cast(unsigned, f); return (u + 0x7fffu + ((u >> 16) & 1u)) >> 16; }
__device__ __forceinline__ unsigned pk2(float lo, float hi) { return f2bf(lo) | (f2bf(hi) << 16); }
__device__ __forceinline__ float bf2f(unsigned short b) { return __builtin_bit_cast(float, (unsigned)b << 16); }
__device__ __forceinline__ float bflo(unsigned w) { return __builtin_bit_cast(float, w << 16); }
__device__ __forceinline__ float bfhi(unsigned w) { return __builtin_bit_cast(float, w & 0xffff0000u); }
typedef __bf16 bf16x2_t __attribute__((ext_vector_type(2)));
__device__ __forceinline__ unsigned cvt_pk_bf16(float lo, float hi) { f32x2 v = {lo, hi}; bf16x2_t b = __builtin_convertvector(v, bf16x2_t); return __builtin_bit_cast(unsigned, b); }
__device__ __forceinline__ float shx(float v, int o, int lane) { return __builtin_bit_cast(float, __builtin_amdgcn_ds_bpermute((lane ^ o) << 2, __builtin_bit_cast(int, v))); }
__device__ __forceinline__ float wave_sum(float v, int lane) {
    (void)lane; int x;
    x = __builtin_amdgcn_update_dpp(0, __builtin_bit_cast(int, v), 0xB1, 0xf, 0xf, true); v += __builtin_bit_cast(float, x);
    x = __builtin_amdgcn_update_dpp(0, __builtin_bit_cast(int, v), 0x4E, 0xf, 0xf, true); v += __builtin_bit_cast(float, x);
    x = __builtin_amdgcn_update_dpp(0, __builtin_bit_cast(int, v), 0x141, 0xf, 0xf, true); v += __builtin_bit_cast(float, x);
    x = __builtin_amdgcn_update_dpp(0, __builtin_bit_cast(int, v), 0x140, 0xf, 0xf, true); v += __builtin_bit_cast(float, x);
    x = __builtin_amdgcn_update_dpp(0, __builtin_bit_cast(int, v), 0x142, 0xa, 0xf, false); v += __builtin_bit_cast(float, x);
    x = __builtin_amdgcn_update_dpp(0, __builtin_bit_cast(int, v), 0x143, 0xc, 0xf, false); v += __builtin_bit_cast(float, x);
    return __builtin_bit_cast(float, __builtin_amdgcn_readlane(__builtin_bit_cast(int, v), 63));
}
__device__ __forceinline__ float sigmoidf_(float x) { return __builtin_amdgcn_rcpf(1.f + __builtin_amdgcn_exp2f(-1.4426950408889634f * x)); }
__device__ __forceinline__ f32x2 gelu_pk(f32x2 v) {
    const f32x2 av = __builtin_elementwise_abs(v), d = av * 0.2316418882f + 1.0f;
    f32x2 t; t.x = __builtin_amdgcn_rcpf(d.x); t.y = __builtin_amdgcn_rcpf(d.y);
    f32x2 q = t * 0.5307027145f + (-0.7265760135f); q = q * t + 0.7107068705f; q = q * t + (-0.142248368f); q = q * t + 0.127414796f; q = q * t;
    const f32x2 s = (v * v) * (-0.72134752044f);
    f32x2 e; e.x = __builtin_amdgcn_exp2f(s.x); e.y = __builtin_amdgcn_exp2f(s.y);
    const f32x2 m = v * (q * e), r = v - m;
    f32x2 o; o.x = v.x < 0.f ? m.x : r.x; o.y = v.y < 0.f ? m.y : r.y; return o;
}
__device__ __forceinline__ f32x4 gelu4(f32x4 v) { f32x2 a = gelu_pk((f32x2){v[0], v[1]}), b = gelu_pk((f32x2){v[2], v[3]}); return (f32x4){a.x, a.y, b.x, b.y}; }
__device__ __forceinline__ f32x4 sigm4(f32x4 v) { return (f32x4){sigmoidf_(v[0]), sigmoidf_(v[1]), sigmoidf_(v[2]), sigmoidf_(v[3])}; }
__device__ __forceinline__ v4u pack8(f32x4 a, f32x4 b) { v4u w; w.x = cvt_pk_bf16(a[0], a[1]); w.y = cvt_pk_bf16(a[2], a[3]); w.z = cvt_pk_bf16(b[0], b[1]); w.w = cvt_pk_bf16(b[2], b[3]); return w; }

__device__ __forceinline__ float sat8(float x) { return __builtin_amdgcn_fmed3f(x, -448.f, 448.f); }
__device__ __forceinline__ unsigned pk4_fp8(float a, float b, float c, float d) { int r = __builtin_amdgcn_cvt_pk_fp8_f32(sat8(a), sat8(b), 0, false); r = __builtin_amdgcn_cvt_pk_fp8_f32(sat8(c), sat8(d), r, true); return (unsigned)r; }
#ifndef MOE2_FP8
#define MOE2_FP8 1
#endif
#ifndef MOE1_FP8
#define MOE1_FP8 1
#endif
constexpr float WGU8_SCALE = MOE1_FP8 ? 32.f : 1.f, WD8_SCALE = MOE2_FP8 ? 16.f : 1.f, HID8_SCALE = MOE2_FP8 ? 8.f : 1.f;
constexpr float YBC8_SCALE = 16.f, WBR8_SCALE = 32.f;
constexpr float MRG8_SCALE = 16.f, WOUT8_SCALE = 32.f;
constexpr float WG8_SCALE = 32.f;
#define XB_TMO      128
#define XB_XCNT(j)  (256  + 64 * (j))
#define XB_XSUB(j)  (1280 + 64 * (j))
#define XB_XGEN(j)  (2304 + 64 * (j))
#define XB_TOP      3328
#define XB_TOPGEN   3392
#define XCD_BAR_WORDS 3456
#define XB_SPIN_CAP (1u << 18)
__device__ __forceinline__ unsigned xb_ld(unsigned* p)              { return __hip_atomic_load(p, __ATOMIC_RELAXED, __HIP_MEMORY_SCOPE_AGENT); }
__device__ __forceinline__ unsigned xb_add(unsigned* p, unsigned v) { return __hip_atomic_fetch_add(p, v, __ATOMIC_RELAXED, __HIP_MEMORY_SCOPE_AGENT); }
__device__ __forceinline__ unsigned xb_xcc_id() { return (unsigned)__builtin_amdgcn_s_getreg((3 << 11) | 20) & 0xFu; }
#define XB_SPIN(cond, bar) do { unsigned _sp = 0; while (cond) { __builtin_amdgcn_s_sleep(1); \
    if ((++_sp & 255u) == 0u) { if (xb_ld(&(bar)[XB_TMO])) break; if (_sp > XB_SPIN_CAP) { atomicAdd(&(bar)[XB_TMO], 1u); break; } } } } while (0)
struct XcdBarrier { unsigned* bar; unsigned x; volatile LAS unsigned* st; };
__device__ __forceinline__ XcdBarrier xcd_barrier_post(unsigned* bar, volatile LAS unsigned* st) {
    XcdBarrier b; b.bar = bar; b.x = xb_xcc_id(); b.st = st;
    if (threadIdx.x == 0) (void)xb_add(&bar[XB_XCNT(b.x)], 1u);
    return b;
}
__device__ __forceinline__ void xcd_barrier_complete(unsigned* bar, unsigned x, unsigned& nloc, unsigned& nx) {
    const unsigned G = gridDim.x * gridDim.y * gridDim.z;
    unsigned sum, cnt, mine, sp = 0u;
    for (;;) {
        sum = 0u; cnt = 0u; mine = 0u;
#pragma unroll 1
        for (unsigned j = 0; j < 16; ++j) { const unsigned c = xb_ld(&bar[XB_XCNT(j)]); sum += c; cnt += (c > 0u) ? 1u : 0u; mine = (j == x) ? c : mine; }
        if (sum == G) break;
        __builtin_amdgcn_s_sleep(1);
        if ((++sp & 255u) == 0u) { if (xb_ld(&bar[XB_TMO])) break; if (sp > XB_SPIN_CAP) { atomicAdd(&bar[XB_TMO], 1u); break; } }
    }
    nloc = mine > 0u ? mine : 1u; nx = cnt > 0u ? cnt : 1u;
}
__device__ __forceinline__ void xcd_barrier(const XcdBarrier& b) {
    asm volatile("s_waitcnt vmcnt(0)" ::: "memory");
    __syncthreads();
    if (threadIdx.x == 0) {
        unsigned* bar = b.bar;
        __builtin_amdgcn_s_waitcnt(0);
        unsigned nloc = b.st[0], nx = b.st[1];
        if (nloc == 0u) { xcd_barrier_complete(bar, b.x, nloc, nx); b.st[0] = nloc; b.st[1] = nx; }
        const unsigned old = xb_add(&bar[XB_XSUB(b.x)], 1u);
        const unsigned gen = old / nloc;
        if (old + 1u == (gen + 1u) * nloc) {
            __builtin_amdgcn_fence(__ATOMIC_RELEASE, "agent");
            asm volatile("s_waitcnt vmcnt(0)" ::: "memory");
            const unsigned og = xb_add(&bar[XB_TOP], 1u);
            const unsigned tg = og / nx;
            if (og + 1u == (tg + 1u) * nx) xb_add(&bar[XB_TOPGEN], 1u);
            else XB_SPIN(xb_ld(&bar[XB_TOPGEN]) == tg, bar);
            __builtin_amdgcn_fence(__ATOMIC_ACQUIRE, "agent");
            xb_add(&bar[XB_XGEN(b.x)], 1u);
            asm volatile("s_waitcnt vmcnt(0)" ::: "memory");
        } else {
            XB_SPIN(xb_ld(&bar[XB_XGEN(b.x)]) == gen, bar);
            __builtin_amdgcn_fence(__ATOMIC_ACQUIRE, "agent");
            asm volatile("s_waitcnt vmcnt(0)" ::: "memory");
        }
    }
    __syncthreads();
}

struct Unit { const GAS char* A; const GAS char* B; const GAS char* A2; const GAS char* B2; int pm, pn, aux, nv; };

constexpr int NXCD = 8, WGM = 8;
__device__ __forceinline__ void tile_order(int L, int nM, int nN, int& pm, int& pn) {
    const int nwg = nM * nN;
    int wgid = L; { const int q = nwg / NXCD, r = nwg % NXCD, xcd = wgid % NXCD, off = wgid / NXCD; wgid = (xcd < r ? xcd * (q + 1) : r * (q + 1) + (xcd - r) * q) + off; }
    const int nig = WGM * nN, gid = wgid / nig, fm = gid * WGM, gsz = (nM - fm) < WGM ? (nM - fm) : WGM;
    pm = fm + ((wgid % nig) % gsz); pn = (wgid % nig) / gsz;
}

struct SchedInProj {
    static constexpr bool GATHER = false;
    const GAS char* H; const GAS char* Win; const GAS char* MemH; const GAS char* Wmkv; int G, c, mode;
    __device__ __forceinline__ bool next(int i, Unit& u) const {
        int L = i * G + c; constexpr int N1 = 64 * 8, N2 = 4 * 8;
        if (mode == 2) L += N1;
        if (L >= (mode == 1 ? N1 : N1 + N2)) return false;
        if (L < N1) { int pm, pn; tile_order(L, 64, 8, pm, pn); u.pm = pm; u.pn = pn; u.aux = 0; u.A = H + (size_t)pm * 256 * D * 2; u.B = Win + (size_t)pn * 256 * D * 2; }
        else { const int r = L - N1; u.pm = r & 3; u.pn = r >> 2; u.aux = 1; u.A = MemH + (size_t)u.pm * 256 * D * 2; u.B = Wmkv + (size_t)u.pn * 256 * D * 2; }
        u.A2 = u.A; u.B2 = u.B; return true;
    }
};
struct SchedGate {
    static constexpr bool GATHER = false;
    const GAS char* H8; const GAS char* Wg8; int G, c, rem, ibeg, iend;
    __device__ __forceinline__ bool next(int i0, Unit& u) const {
        constexpr int NF = 64 * 34; int L; const int i = i0 + ibeg; if (i >= iend) return false;
        const int nh = (NF + 3 * rem + G - 1) / G;
        if (rem == 0 || nh < 3) { L = i * G + c; if (L >= NF) return false; }
        else { const int Gh = G - rem; const int nhT = nh * Gh < NF ? nh * Gh : NF;
            if (c >= rem) { L = i * Gh + (c - rem); if (i >= nh || L >= nhT) return false; }
            else { L = nhT + i * rem + c; if (L >= NF) return false; } }
        int pm, pn; tile_order(L, 64, 34, pm, pn); u.pm = pm; u.pn = pn; u.aux = 0;
        u.A = H8 + (size_t)pm * 256 * D; u.B = Wg8 + (size_t)pn * 256 * D; u.A2 = u.A; u.B2 = u.B; return true;
    }
};
struct SchedMerge {
    static constexpr bool GATHER = false;
    const GAS char* Y; const GAS char* Wbr; int G, c;
    __device__ __forceinline__ bool next(int i, Unit& u) const {
        const int L = i * G + c;
        if (L >= 64 * 8) return false;
        int pm, pn; tile_order(L, 64, 8, pm, pn); u.pm = pm; u.pn = pn; u.aux = 0;
        u.A = Y + (size_t)pm * 256 * 6144; u.B = Wbr + (size_t)pn * 256 * 1024 * 2; u.A2 = u.A; u.B2 = u.B; return true;
    }
};
struct SchedMerge8 {
    static constexpr bool GATHER = false;
    const GAS char* Y; const GAS char* Wbr; int G, c;
    __device__ __forceinline__ bool next(int i, Unit& u) const {
        const int j = i >> 1, n = 1 + (i & 1); const int L = j * G + c;
        if (L >= 64 * 8) return false;
        int pm, pn; tile_order(L, 64, 8, pm, pn); u.pm = pm; u.pn = pn; u.aux = n;
        u.A = Y + (size_t)pm * 256 * 6144 + 1024 + (size_t)n * 1024; u.B = Wbr + (size_t)(n + 1) * 2048 * 1024 + (size_t)pn * 256 * 1024; u.A2 = u.A; u.B2 = u.B; return true;
    }
};
struct SchedOut {
    static constexpr bool GATHER = false;
    const GAS char* Mg; const GAS char* Wout; int G, c, esz;
    __device__ __forceinline__ bool next(int i, Unit& u) const {
        const int L = i * G + c; if (L >= 64 * 8) return false;
        int pm, pn; tile_order(L, 64, 8, pm, pn); u.pm = pm; u.pn = pn; u.aux = 0;
        u.A = Mg + (size_t)pm * 256 * D * esz; u.B = Wout + (size_t)pn * 256 * D * esz; u.A2 = u.A; u.B2 = u.B; return true;
    }
};
__device__ __forceinline__ int bucket_of_tile(const volatile LAS unsigned* lw, int rt) {
    int b = 0;
#pragma unroll 1
    for (int k = 1; k < NBUCKET; ++k) b = ((int)lw[LW_TSTART + k] <= rt) ? k : b;
    return b;
}
__device__ __forceinline__ void bucket_experts(int b, int& elo, int& ehi) { const int g = b / 6, pi = b - 6 * g; elo = 4 * g + ((2368 >> (2 * pi)) & 3); ehi = 4 * g + ((4025 >> (2 * pi)) & 3); }
struct SchedMoe1 {
    static constexpr bool GATHER = true;
    const GAS char* Hb; const GAS char* Wgu; const GAS int* perm; const volatile LAS unsigned* lw; int G, vcu;
    __device__ __forceinline__ bool next(int i, Unit& u) const {
        const int L = i * G + vcu, rt = L >> 3, pn = L & 7; const int ntile = (int)lw[LW_NT];
        if (rt >= ntile) return false;
        const int b = bucket_of_tile(lw, rt); int elo, ehi; bucket_experts(b, elo, ehi);
        const int e = __builtin_amdgcn_readfirstlane(pn < 4 ? elo : ehi); const int lt = rt - (int)lw[LW_TSTART + b];
        u.pm = rt; u.pn = pn; u.aux = __builtin_amdgcn_readfirstlane(b * T + lt * 256); u.nv = __builtin_amdgcn_readfirstlane((int)lw[LW_CNT + b] - lt * 256);
        u.A = Hb; u.B = Wgu + ((size_t)e * 1024 + (size_t)(pn & 3) * 256) * D * (MOE1_FP8 ? 1 : 2); u.A2 = u.A; u.B2 = u.B; return true;
    }
    __device__ __forceinline__ void aoffs(const Unit& u, const int (&R)[2], const int (&Cc)[2], unsigned (&o)[2][2]) const {
#pragma unroll
        for (int h = 0; h < 2; ++h)
#pragma unroll
            for (int i = 0; i < 2; ++i) { const int rr = 128 * h + R[i]; int tok = perm[u.aux + (rr < u.nv ? rr : 0)]; tok = rr < u.nv ? tok : 0; o[h][i] = (unsigned)tok * (unsigned)(D * (MOE1_FP8 ? 1 : 2)) + (unsigned)(Cc[i] * 2); }
    }
};
struct SchedMoe2 {
    static constexpr bool GATHER = false;
    const GAS char* HID; const GAS char* Wd; const volatile LAS unsigned* lw; int G, vcu;
    __device__ __forceinline__ bool next(int i, Unit& u) const {
        const int L = i * G + vcu, rt = L >> 3, pn = L & 7; const int ntile = (int)lw[LW_NT];
        if (rt >= ntile) return false;
        const int b = bucket_of_tile(lw, rt); int elo, ehi; bucket_experts(b, elo, ehi);
        elo = __builtin_amdgcn_readfirstlane(elo); ehi = __builtin_amdgcn_readfirstlane(ehi); const int lt = rt - (int)lw[LW_TSTART + b];
        u.pm = rt; u.pn = pn; u.aux = __builtin_amdgcn_readfirstlane(b * T + lt * 256); u.nv = __builtin_amdgcn_readfirstlane((int)lw[LW_CNT + b] - lt * 256);
        constexpr int ES = MOE2_FP8 ? 1 : 2;
        u.A = HID + (size_t)rt * 256 * 1024 * ES; u.A2 = u.A + 512 * ES;
        u.B = Wd + ((size_t)elo * D + (size_t)pn * 256) * DFF * ES; u.B2 = Wd + ((size_t)ehi * D + (size_t)pn * 256) * DFF * ES; return true;
    }
};

struct EpiInProj {
    static constexpr bool PAIR = false, HASPRE = false, HASROW = false, WIDE8 = false;
    GAS bf16 *P1, *P2, *P3, *P4, *KVM;
    __device__ __forceinline__ void tile8(const Unit& u, int r, int c, f32x4 v0, f32x4 v1) const {
        const size_t row = (size_t)u.pm * 256 + r; const int pn = u.pn;
        if (u.aux) { *(GAS v4u*)(KVM + row * 2048 + pn * 256 + c) = pack8(v0, v1); return; }
        *(GAS v4u*)(P1 + row * 2048 + pn * 256 + c) = pack8(gelu4(v0), gelu4(v1));
    }
};
struct EpiNull { static constexpr bool PAIR = false, HASPRE = false, HASROW = false, WIDE8 = false; GAS float* sink;
    __device__ __forceinline__ void tile8(const Unit& u, int r, int c, f32x4 v0, f32x4 v1) const { if (v0[0] == 1.2345e30f && v1[3] == -7.7e29f) sink[r] = 1.f; } };
struct EpiGate {
    static constexpr bool PAIR = false, HASPRE = false, HASROW = false;
    GAS unsigned char* P4; GAS bf16* P2; GAS bf16* P3;
    __device__ __forceinline__ void tile8(const Unit& u, int r, int c, f32x4 v0, f32x4 v1) const {
        const size_t row = (size_t)u.pm * 256 + r; const float sc = 1.f / WG8_SCALE;
        if (u.pn < 6) { *(GAS v4u*)(P2 + row * 1536 + u.pn * 256 + c) = pack8(v0 * sc, v1 * sc); return; }
        if (u.pn < 10) { *(GAS v4u*)(P3 + row * 1024 + (u.pn - 6) * 256 + c) = pack8(v0 * sc, v1 * sc); return; }
        *(GAS v2u*)(P4 + row * 6144 + (u.pn - 10) * 256 + c) = pack8u(v0, v1);
    }
    static constexpr bool WIDE8 = true;
    __device__ __forceinline__ bool wide(const Unit& u) const { return u.pn >= 10; }
    __device__ __forceinline__ v2u pack8u(f32x4 v0, f32x4 v1) const { const float sc = 1.f / WG8_SCALE;
        const f32x4 a = sigm4(v0 * sc) * 255.f + 0.5f, b = sigm4(v1 * sc) * 255.f + 0.5f;
        v2u o; o.x = (unsigned)a[0] | ((unsigned)a[1] << 8) | ((unsigned)a[2] << 16) | ((unsigned)a[3] << 24); o.y = (unsigned)b[0] | ((unsigned)b[1] << 8) | ((unsigned)b[2] << 16) | ((unsigned)b[3] << 24); return o; }
    __device__ __forceinline__ void store16(const Unit& u, int r, int c, v4u o) const { *(GAS v4u*)(P4 + ((size_t)u.pm * 256 + r) * 6144 + (u.pn - 10) * 256 + c) = o; }
};
struct EpiMerge {
    static constexpr bool PAIR = false, HASPRE = true, HASROW = false;
    const GAS unsigned char* P4; GAS bf16* MP; GAS bf16* MG; float sc; int out8;
    struct Pre { v2u g; v4u p; };
    __device__ __forceinline__ void pre(const Unit& u, int r, int c, Pre& q) const {
        const size_t row = (size_t)u.pm * 256 + r; const int col = u.pn * 256 + c;
        q.g = *(const GAS v2u*)(P4 + row * 6144 + u.aux * 2048 + col);
        if (u.aux > 0) q.p = *(const GAS v4u*)(MP + row * D + col); else { unsigned zz = 0u; asm volatile("" : "+v"(zz)); q.p = (v4u){zz, zz, zz, zz}; }
    }
    __device__ __forceinline__ void post(const Unit& u, int r, int c, f32x4 v0, f32x4 v1, const Pre& q) const {
        const size_t row = (size_t)u.pm * 256 + r; const int col = u.pn * 256 + c;
        f32x4 a = (f32x4){(float)(q.g.x & 255u), (float)((q.g.x >> 8) & 255u), (float)((q.g.x >> 16) & 255u), (float)(q.g.x >> 24)} * (v0 * sc) + (f32x4){bflo(q.p.x), bfhi(q.p.x), bflo(q.p.y), bfhi(q.p.y)};
        f32x4 b = (f32x4){(float)(q.g.y & 255u), (float)((q.g.y >> 8) & 255u), (float)((q.g.y >> 16) & 255u), (float)(q.g.y >> 24)} * (v1 * sc) + (f32x4){bflo(q.p.z), bfhi(q.p.z), bflo(q.p.w), bfhi(q.p.w)};
        if (u.aux < 2) *(GAS v4u*)(MP + row * D + col) = pack8(a, b);
        else if (out8) { a = a * MRG8_SCALE; b = b * MRG8_SCALE; *(GAS v2u*)((GAS unsigned char*)MG + (WS_H8 - WS_H) + row * D + col) = (v2u){pk4_fp8(a[0], a[1], a[2], a[3]), pk4_fp8(b[0], b[1], b[2], b[3])}; }
        else *(GAS v4u*)(MG + row * D + col) = pack8(a, b);
    }
    __device__ __forceinline__ void tile8(const Unit& u, int r, int c, f32x4 v0, f32x4 v1) const { Pre q; pre(u, r, c, q); post(u, r, c, v0, v1, q); }
};
struct EpiOut {
    static constexpr bool PAIR = false, HASPRE = true, HASROW = false;
    const GAS float* xin; GAS bf16* xb; int in32; float sc;
    struct Pre { f32x4 a, b; };
    __device__ __forceinline__ void pre(const Unit& u, int r, int c, Pre& q) const {
        const size_t off = ((size_t)u.pm * 256 + r) * D + u.pn * 256 + c;
        if (in32) { q.a = *(const GAS f32x4*)(xin + off); q.b = *(const GAS f32x4*)(xin + off + 4); }
        else { const v4u t = *(const GAS v4u*)(xb + off); q.a = (f32x4){bflo(t.x), bfhi(t.x), bflo(t.y), bfhi(t.y)}; q.b = (f32x4){bflo(t.z), bfhi(t.z), bflo(t.w), bfhi(t.w)}; }
    }
    __device__ __forceinline__ void post(const Unit& u, int r, int c, f32x4 v0, f32x4 v1, const Pre& q) const {
        const size_t off = ((size_t)u.pm * 256 + r) * D + u.pn * 256 + c; *(GAS v4u*)(xb + off) = pack8(q.a + v0 * sc, q.b + v1 * sc);
    }
    __device__ __forceinline__ void tile8(const Unit& u, int r, int c, f32x4 v0, f32x4 v1) const { Pre q; pre(u, r, c, q); post(u, r, c, v0, v1, q); }
};
struct EpiMoe1 {
    static constexpr bool PAIR = true, HASPRE = false, HASROW = true;
    const GAS float* roww; GAS bf16* HID;
    typedef f32x2 RowT;
    __device__ __forceinline__ f32x2 rowload(const Unit& u, int r) const { const bool ok = r < u.nv; const GAS float* p = roww + (size_t)(u.aux + (ok ? r : 0)) * 4; const f32x2 v = (f32x2){p[u.pn >> 2], p[2]}; return ok ? v : (f32x2){0.f, 0.f}; }
    __device__ __forceinline__ void pair8w(const Unit& u, int r, int c, f32x4 g0, f32x4 g1, f32x4 u0, f32x4 u1, f32x2 wr2) const {
        const size_t row = (size_t)u.pm * 256 + r; const int seg = u.pn >> 2; const float rstd = wr2[1] * (1.f / WGU8_SCALE), w = wr2[0] * rstd * HID8_SCALE;
        f32x4 a, b;
#pragma unroll
        for (int k = 0; k < 4; ++k) { const float ga = g0[k] * rstd, gb = g1[k] * rstd; a[k] = ga * sigmoidf_(ga) * u0[k] * w; b[k] = gb * sigmoidf_(gb) * u1[k] * w; }
        if (MOE2_FP8) *(GAS v2u*)((GAS unsigned char*)HID + row * 1024 + seg * 512 + (u.pn & 3) * 128 + c) = (v2u){pk4_fp8(a[0], a[1], a[2], a[3]), pk4_fp8(b[0], b[1], b[2], b[3])};
        else *(GAS v4u*)(HID + row * 1024 + seg * 512 + (u.pn & 3) * 128 + c) = pack8(a, b);
    }
    __device__ __forceinline__ void pair8(const Unit& u, int r, int c, f32x4 g0, f32x4 g1, f32x4 u0, f32x4 u1) const { pair8w(u, r, c, g0, g1, u0, u1, rowload(u, r)); }
};
struct EpiMoe2 {
    static constexpr bool PAIR = false, HASPRE = true, HASROW = true;
    const GAS int* perm; GAS bf16* xb; GAS float* xout; int last;
    typedef int RowT;
    struct Pre { v4u p; };
    __device__ __forceinline__ int rowload(const Unit& u, int r) const { const bool ok = r < u.nv; const int tok = perm[u.aux + (ok ? r : 0)]; return ok ? tok : -1; }
    __device__ __forceinline__ void pre(const Unit& u, int r, int c, Pre& q, int tok) const {
        q.p = *(const GAS v4u*)(xb + (size_t)(tok < 0 ? 0 : tok) * D + u.pn * 256 + c);
    }
    __device__ __forceinline__ void post(const Unit& u, int r, int c, f32x4 v0, f32x4 v1, const Pre& q, int tok) const {
        if (tok < 0) return;
        const float sc = 1.f / (HID8_SCALE * WD8_SCALE); const size_t off = (size_t)tok * D + u.pn * 256 + c;
        const f32x4 a = (f32x4){bflo(q.p.x), bfhi(q.p.x), bflo(q.p.y), bfhi(q.p.y)} + v0 * sc, b = (f32x4){bflo(q.p.z), bfhi(q.p.z), bflo(q.p.w), bfhi(q.p.w)} + v1 * sc;
        if (last) { *(GAS f32x4*)(xout + off) = a; *(GAS f32x4*)(xout + off + 4) = b; }
        else *(GAS v4u*)(xb + off) = pack8(a, b);
    }
    __device__ __forceinline__ void tile8(const Unit& u, int r, int c, f32x4 v0, f32x4 v1) const { Pre q; const int tok = rowload(u, r); pre(u, r, c, q, tok); post(u, r, c, v0, v1, q, tok); }
};

template <class Epi, class Sched, int NSEG>
__device__ __forceinline__ void gemm_simple(int lda, int ldb, int nt, const Sched& S, const Epi& E) {
    const int tid = threadIdx.x, wid = tid >> 6, lane = tid & 63, fr = lane & 15, fq = lane >> 4;
    Unit u;
    for (int i = 0; S.next(i, u); ++i) {
        constexpr int NCG = Epi::PAIR ? 4 : 8;
        for (int sub = wid; sub < 16 * NCG; sub += NWAVES) {
            const int rt = sub / NCG, cg = sub % NCG;
            f32x4 acc[4];
#pragma unroll
            for (int k = 0; k < 4; ++k) acc[k] = (f32x4){0.f, 0.f, 0.f, 0.f};
            for (int seg = 0; seg < NSEG; ++seg) {
                size_t arow = (size_t)(rt * 16 + fr) * lda;
                if constexpr (Sched::GATHER) { const int R1[2] = {(rt * 16 + fr) & 127, 0}; const int C1[2] = {0, 0}; unsigned o[2][2]; S.aoffs(u, R1, C1, o); arow = o[(rt * 16 + fr) >> 7][0]; }
                const GAS char* Ab = (seg ? u.A2 : u.A) + arow + fq * 16;
                const GAS char* Bb = (seg ? u.B2 : u.B) + fq * 16;
                const int brow0 = cg * 32 + 8 * (fr >> 2) + (fr & 3);
                for (int ks = 0; ks < nt * 2; ++ks) {
                    const bf16x8 a = *(const GAS bf16x8*)(Ab + ks * 64);
#pragma unroll
                    for (int n = 0; n < 2; ++n) {
                        const bf16x8 w = *(const GAS bf16x8*)(Bb + (size_t)(brow0 + 4 * n) * ldb + ks * 64);
                        acc[n] = __builtin_amdgcn_mfma_f32_16x16x32_bf16(w, a, acc[n], 0, 0, 0);
                        if (Epi::PAIR) { const bf16x8 w2 = *(const GAS bf16x8*)(Bb + (size_t)(128 + brow0 + 4 * n) * ldb + ks * 64);
                            acc[2 + n] = __builtin_amdgcn_mfma_f32_16x16x32_bf16(w2, a, acc[2 + n], 0, 0, 0); }
                    }
                }
            }
            if constexpr (Epi::PAIR) E.pair8(u, rt * 16 + fr, cg * 32 + 8 * fq, acc[0], acc[1], acc[2], acc[3]);
            else E.tile8(u, rt * 16 + fr, cg * 32 + 8 * fq, acc[0], acc[1]);
        }
    }
}

#ifndef PG8_ALIGN_EPI
#define PG8_ALIGN_EPI 1
#endif
namespace pg8 {
constexpr int BM = 256, BK = 64, HALF = 128, HTB = HALF * BK * 2, STAGE_BYTES = 8 * HTB;
__device__ __forceinline__ int lds_byte(int r, int c) { const int st = (r >> 4) * 2 + (c >> 5), rr = r & 15, cc = c & 31, ob = rr * 64 + cc * 2; return st * 1024 + (ob ^ (((ob >> 9) & 1) << 5)); }
__device__ __forceinline__ void stage_rc(int b, int& R, int& C) { const int st = b / 1024, sb = b % 1024, swz = sb ^ (((sb >> 9) & 1) << 5); R = (st >> 1) * 16 + swz / 64; C = (st & 1) * 32 + (swz % 64) / 2; }
__device__ __forceinline__ int perm32(int rho) { const int n = rho >> 4, i = rho & 15; return 8 * (i >> 2) + 4 * n + (i & 3); }

__device__ __forceinline__ void glds_saddr(const GAS char* gbase, unsigned voff, unsigned lds_dst) {
    unsigned keep;
    asm volatile("s_mov_b32 %0, m0\n\ts_mov_b32 m0, %3\n\ts_nop 0\n\tglobal_load_lds_dwordx4 %1, %2\n\ts_mov_b32 m0, %0" : "=&s"(keep) : "v"(voff), "s"(gbase), "s"(lds_dst) : "memory");
}
template <class Epi> __device__ __forceinline__ void run_epi(const Epi& E, const f32x4 (&acc)[2][2][4][2], const Unit& u, int wr, int wc, int fr, int fq) {
    if constexpr (Epi::PAIR && Epi::HASROW) {
        typename Epi::RowT rv[2][4];
#pragma unroll
        for (int ai = 0; ai < 2; ++ai)
#pragma unroll
            for (int m = 0; m < 4; ++m) rv[ai][m] = E.rowload(u, ai * HALF + wr * 64 + m * 16 + fr);
#pragma unroll
        for (int ai = 0; ai < 2; ++ai)
#pragma unroll
            for (int m = 0; m < 4; ++m) {
                int r = ai * HALF + wr * 64 + m * 16 + fr; asm volatile("" : "+v"(r) :: "memory");
                E.pair8w(u, r, wc * 32 + 8 * fq, acc[ai][0][m][0], acc[ai][0][m][1], acc[ai][1][m][0], acc[ai][1][m][1], rv[ai][m]);
                asm volatile("" ::: "memory");
            }
    } else if constexpr (Epi::HASPRE) {
        typename std::conditional<Epi::HASROW, int, char>::type rv[2][4];
        if constexpr (Epi::HASROW) {
#pragma unroll
            for (int ai = 0; ai < 2; ++ai)
#pragma unroll
                for (int m = 0; m < 4; ++m) rv[ai][m] = E.rowload(u, ai * HALF + wr * 64 + m * 16 + fr);
        }
#pragma unroll
        for (int ai = 0; ai < 2; ++ai)
#pragma unroll
            for (int mp = 0; mp < 2; ++mp) {
                int r0 = ai * HALF + wr * 64 + (2 * mp) * 16 + fr; asm volatile("" : "+v"(r0) :: "memory");
                const int c0 = wc * 32 + 8 * fq;
                typename Epi::Pre q[2][2];
                if constexpr (Epi::HASROW) {
#pragma unroll
                    for (int mm = 0; mm < 2; ++mm)
#pragma unroll
                        for (int bj = 0; bj < 2; ++bj) E.pre(u, r0 + 16 * mm, bj * HALF + c0, q[mm][bj], rv[ai][2 * mp + mm]);
#pragma unroll
                    for (int mm = 0; mm < 2; ++mm)
#pragma unroll
                        for (int bj = 0; bj < 2; ++bj) E.post(u, r0 + 16 * mm, bj * HALF + c0, acc[ai][bj][2 * mp + mm][0], acc[ai][bj][2 * mp + mm][1], q[mm][bj], rv[ai][2 * mp + mm]);
                } else {
#pragma unroll
                for (int mm = 0; mm < 2; ++mm)
#pragma unroll
                    for (int bj = 0; bj < 2; ++bj) E.pre(u, r0 + 16 * mm, bj * HALF + c0, q[mm][bj]);
#pragma unroll
                for (int mm = 0; mm < 2; ++mm)
#pragma unroll
                    for (int bj = 0; bj < 2; ++bj) E.post(u, r0 + 16 * mm, bj * HALF + c0, acc[ai][bj][2 * mp + mm][0], acc[ai][bj][2 * mp + mm][1], q[mm][bj]);
                }
                asm volatile("" ::: "memory");
            }
    } else {
    if constexpr (!Epi::PAIR && Epi::WIDE8) {
        if (E.wide(u)) {
#pragma unroll
            for (int ai = 0; ai < 2; ++ai)
#pragma unroll
                for (int mp = 0; mp < 2; ++mp) {
                    int r0 = ai * HALF + wr * 64 + (2 * mp) * 16 + fr; asm volatile("" : "+v"(r0) :: "memory");
#pragma unroll
                    for (int bj = 0; bj < 2; ++bj) {
                        v2u a = E.pack8u(acc[ai][bj][2 * mp][0], acc[ai][bj][2 * mp][1]), b = E.pack8u(acc[ai][bj][2 * mp + 1][0], acc[ai][bj][2 * mp + 1][1]);
                        asm volatile("s_nop 1\n\tv_permlane16_swap_b32 %0, %1" : "+v"(a.x), "+v"(b.x));
                        asm volatile("s_nop 1\n\tv_permlane16_swap_b32 %0, %1" : "+v"(a.y), "+v"(b.y));
                        const int odd = fq & 1;
                        E.store16(u, r0 + 16 * odd, bj * HALF + wc * 32 + 8 * (fq - odd), (v4u){a.x, a.y, b.x, b.y});
                    }
                    asm volatile("" ::: "memory");
                }
            return;
        }
    }
#pragma unroll
    for (int ai = 0; ai < 2; ++ai)
#pragma unroll
        for (int m = 0; m < 4; ++m) {
            int r = ai * HALF + wr * 64 + m * 16 + fr; asm volatile("" : "+v"(r) :: "memory");
            if constexpr (Epi::PAIR) E.pair8(u, r, wc * 32 + 8 * fq, acc[ai][0][m][0], acc[ai][0][m][1], acc[ai][1][m][0], acc[ai][1][m][1]);
            else {
#pragma unroll
                for (int bj = 0; bj < 2; ++bj) { E.tile8(u, r, bj * HALF + wc * 32 + 8 * fq, acc[ai][bj][m][0], acc[ai][bj][m][1]); asm volatile("" ::: "memory"); }
            }
            asm volatile("" ::: "memory");
        }
    }
}

#define PG8_KPTR(base, base2, tau) ((NSEG == 2 && (tau) >= nt) ? (base2) + (size_t)((tau) - nt) * kstep : (base) + (size_t)(tau) * kstep)
typedef int v8i __attribute__((ext_vector_type(8)));
template <class Epi, class Sched, int NSEG, bool FP8 = false>
__device__ __forceinline__ void gemm_fast(LAS unsigned char* lds, const int lda, const int ldb, const int nt, const Sched& S, const Epi& E) {
    int tid = threadIdx.x; asm volatile("" : "+v"(tid));
    const int wid = __builtin_amdgcn_readfirstlane(tid >> 6), lane = tid & 63, wr = wid >> 2, wc = wid & 3, fr = lane & 15, fq = lane >> 4;
    const int NT = NSEG * nt;
    unsigned voffB[2]; int RA[2], CA[2];
#pragma unroll
    for (int i = 0; i < 2; ++i) { int R, C; stage_rc(tid * 16 + i * 8192, R, C); const int Rb = (R & ~31) + perm32(R & 31);
        RA[i] = R; CA[i] = C; voffB[i] = (unsigned)(Rb * ldb + C * 2); }
    unsigned vA[2][2], vAn[2][2];
#pragma unroll
    for (int h = 0; h < 2; ++h)
#pragma unroll
        for (int i = 0; i < 2; ++i) { vA[h][i] = (unsigned)((h * HALF + RA[i]) * lda + CA[i] * 2); vAn[h][i] = vA[h][i]; }
    const size_t kstep = (size_t)(BK * 2);
    const size_t hstepB = (size_t)HALF * ldb;
    const unsigned ldsw = (unsigned)wid * 1024u;
    const unsigned lds0 = (unsigned)(size_t)lds;
    const int aoff = lds_byte(wr * 64 + fr, fq * 8), boff = lds_byte(wc * 32 + fr, fq * 8);
    const int aoff8a = aoff, boff8a = boff;
#define PG8_SA(b, h) (((b) * 2 + (h)) * HTB)
#define PG8_SB(b, h) ((4 + (b) * 2 + (h)) * HTB)
#define PG8_STAGE(bufoff, gbase, voff) do { _Pragma("unroll") for (int _i = 0; _i < 2; ++_i) \
        glds_saddr((const GAS char*)(gbase), (voff)[_i], lds0 + (unsigned)((bufoff) + _i * 8192) + ldsw); } while (0)
#define PG8_LDA(dst, b, h) do { _Pragma("unroll") for (int m = 0; m < 4; ++m) _Pragma("unroll") for (int k = 0; k < 2; ++k) dst[m][k] = *(const LAS bf16x8*)(lds + PG8_SA(b, h) + aoff + m * 2048 + k * 1024); } while (0)
#define PG8_LDB(dst, b, h) do { _Pragma("unroll") for (int n = 0; n < 2; ++n) _Pragma("unroll") for (int k = 0; k < 2; ++k) dst[n][k] = *(const LAS bf16x8*)(lds + PG8_SB(b, h) + boff + n * 2048 + k * 1024); } while (0)
#define PG8_MMA(ai, bj, At, Bt) do { __builtin_amdgcn_s_setprio(1); _Pragma("unroll") for (int m = 0; m < 4; ++m) _Pragma("unroll") for (int n = 0; n < 2; ++n) _Pragma("unroll") for (int k = 0; k < 2; ++k) \
        acc[ai][bj][m][n] = __builtin_amdgcn_mfma_f32_16x16x32_bf16(Bt[n][k], At[m][k], acc[ai][bj][m][n], 0, 0, 0); __builtin_amdgcn_s_setprio(0); } while (0)
#define PG8_LD8(dst, off) do { const v4u lo_ = *(const LAS v4u*)(lds + (off)); (dst)[0] = (int)lo_.x; (dst)[1] = (int)lo_.y; (dst)[2] = (int)lo_.z; (dst)[3] = (int)lo_.w; } while (0)
#define PG8_LD8H(dst, off) do { const v4u hi_ = *(const LAS v4u*)(lds + (off)); (dst)[4] = (int)hi_.x; (dst)[5] = (int)hi_.y; (dst)[6] = (int)hi_.z; (dst)[7] = (int)hi_.w; } while (0)
#define PG8_LDA8(dst, b, h) do { _Pragma("unroll") for (int m = 0; m < 4; ++m) { PG8_LD8(dst[m], PG8_SA(b, h) + aoff8a + m * 2048); PG8_LD8H(dst[m], PG8_SA(b, h) + aoff8a + 1024 + m * 2048); } } while (0)
#define PG8_LDB8(dst, b, h) do { _Pragma("unroll") for (int n = 0; n < 2; ++n) { PG8_LD8(dst[n], PG8_SB(b, h) + boff8a + n * 2048); PG8_LD8H(dst[n], PG8_SB(b, h) + boff8a + 1024 + n * 2048); } } while (0)
#define PG8_MMA8(ai, bj, A8_, B8_) do { __builtin_amdgcn_s_setprio(1); _Pragma("unroll") for (int m = 0; m < 4; ++m) _Pragma("unroll") for (int n = 0; n < 2; ++n) \
        asm volatile("v_mfma_f32_16x16x128_f8f6f4 %0, %1, %2, %0" : "+v"(acc[ai][bj][m][n]) : "v"(B8_[n]), "v"(A8_[m]));     __builtin_amdgcn_s_setprio(0); } while (0)
#ifdef DRAIN_ALL
#define PG8_WAIT_V(n) asm volatile("s_waitcnt vmcnt(0)" ::: "memory")
#else
#define PG8_WAIT_V(n) asm volatile("s_waitcnt vmcnt(" #n ")" ::: "memory")
#endif
#define PG8_WAIT_L(n) asm volatile("s_waitcnt lgkmcnt(" #n ")" ::: "memory")
#define PG8_BAR __builtin_amdgcn_s_barrier()
#define PG8_SCHED __builtin_amdgcn_sched_barrier(0)
    Unit cur, nxt; int ui = 0;
    if (!S.next(0, cur)) return;
    if constexpr (Sched::GATHER) S.aoffs(cur, RA, CA, vA);
    f32x4 acc[2][2][4][2];
#pragma unroll
    for (int a = 0; a < 2; ++a)
#pragma unroll
        for (int b = 0; b < 2; ++b)
#pragma unroll
            for (int m = 0; m < 4; ++m)
#pragma unroll
                for (int n = 0; n < 2; ++n) acc[a][b][m][n] = (f32x4){0.f, 0.f, 0.f, 0.f};
    if constexpr (FP8) {
#pragma unroll
        for (int a = 0; a < 2; ++a)
#pragma unroll
            for (int b = 0; b < 2; ++b)
#pragma unroll
                for (int m = 0; m < 4; ++m)
#pragma unroll
                    for (int n = 0; n < 2; ++n) asm volatile("" : "+v"(acc[a][b][m][n]));
        asm volatile("s_nop 7\n\ts_nop 7" ::: "memory");
    }
    int sc127 = 127; asm volatile("" : "+v"(sc127));
    bf16x8 At[4][2], B0[2][2], B1[2][2]; v8i A8[4], B80[2], B81[2];
    {
        const GAS char* cA = cur.A; const GAS char* cB = cur.B;
        PG8_STAGE(PG8_SB(0, 0), cB, voffB); PG8_STAGE(PG8_SB(0, 1), cB + hstepB, voffB); PG8_STAGE(PG8_SA(0, 0), cA, vA[0]); PG8_STAGE(PG8_SA(0, 1), cA, vA[1]);
        if (wr == 1) PG8_BAR;
        PG8_WAIT_V(2); PG8_BAR;
        PG8_STAGE(PG8_SB(1, 0), cB + kstep, voffB); PG8_STAGE(PG8_SA(1, 0), cA + kstep, vA[0]); PG8_STAGE(PG8_SB(1, 1), cB + hstepB + kstep, voffB);
        PG8_WAIT_V(6); PG8_BAR;
    }
    for (;;) {
        const bool has_next = S.next(ui + 1, nxt);
        if (!has_next) nxt = cur;
        if constexpr (Sched::GATHER) { if (has_next) S.aoffs(nxt, RA, CA, vAn); else {
#pragma unroll
            for (int h = 0; h < 2; ++h)
#pragma unroll
                for (int i = 0; i < 2; ++i) vAn[h][i] = vA[h][i]; } }
        for (int t = 0; t < NT; t += 2) {
            const bool last = (t == NT - 2);
            const GAS char* a1 = PG8_KPTR(cur.A, cur.A2, t + 1);
            const GAS char* a2 = last ? nxt.A : PG8_KPTR(cur.A, cur.A2, t + 2); const GAS char* b2 = last ? nxt.B : PG8_KPTR(cur.B, cur.B2, t + 2);
            const GAS char* a3 = a2 + kstep; const GAS char* b3 = b2 + kstep;
            unsigned sa0[2], sa1[2];
#pragma unroll
            for (int i = 0; i < 2; ++i) { if constexpr (Sched::GATHER) { sa0[i] = last ? vAn[0][i] : vA[0][i]; sa1[i] = last ? vAn[1][i] : vA[1][i]; } else { sa0[i] = vA[0][i]; sa1[i] = vA[1][i]; } }
            if constexpr (FP8) { PG8_LDB8(B80, 0, 0); PG8_LDB8(B81, 0, 1); PG8_SCHED; PG8_LDA8(A8, 0, 0); } else { PG8_LDB(B0, 0, 0); PG8_LDB(B1, 0, 1); PG8_SCHED; PG8_LDA(At, 0, 0); } PG8_STAGE(PG8_SA(1, 1), a1, vA[1]);
            PG8_WAIT_V(8); PG8_WAIT_L(0); PG8_BAR; if constexpr (FP8) { PG8_MMA8(0, 0, A8, B80); PG8_MMA8(0, 1, A8, B81); } else { PG8_MMA(0, 0, At, B0); PG8_MMA(0, 1, At, B1); } PG8_BAR; PG8_SCHED;
            if constexpr (FP8) { PG8_LDA8(A8, 0, 1); } else { PG8_LDA(At, 0, 1); } PG8_STAGE(PG8_SB(0, 0), b2, voffB); PG8_STAGE(PG8_SB(0, 1), b2 + hstepB, voffB); PG8_STAGE(PG8_SA(0, 0), a2, sa0);
            PG8_WAIT_V(8); PG8_WAIT_L(0); PG8_BAR; if constexpr (FP8) { PG8_MMA8(1, 0, A8, B80); PG8_MMA8(1, 1, A8, B81); } else { PG8_MMA(1, 0, At, B0); PG8_MMA(1, 1, At, B1); } PG8_BAR; PG8_SCHED;
            if constexpr (FP8) { PG8_LDB8(B80, 1, 0); PG8_LDB8(B81, 1, 1); PG8_SCHED; PG8_LDA8(A8, 1, 0); } else { PG8_LDB(B0, 1, 0); PG8_LDB(B1, 1, 1); PG8_SCHED; PG8_LDA(At, 1, 0); } PG8_STAGE(PG8_SA(0, 1), a2, sa1);
            PG8_WAIT_V(8); PG8_WAIT_L(0); PG8_BAR; if constexpr (FP8) { PG8_MMA8(0, 0, A8, B80); PG8_MMA8(0, 1, A8, B81); } else { PG8_MMA(0, 0, At, B0); PG8_MMA(0, 1, At, B1); } PG8_BAR; PG8_SCHED;
            if constexpr (FP8) { PG8_LDA8(A8, 1, 1); } else { PG8_LDA(At, 1, 1); } PG8_STAGE(PG8_SB(1, 0), b3, voffB); PG8_STAGE(PG8_SB(1, 1), b3 + hstepB, voffB); PG8_STAGE(PG8_SA(1, 0), a3, sa0);
            PG8_WAIT_V(8); PG8_WAIT_L(0); PG8_BAR; if constexpr (FP8) { PG8_MMA8(1, 0, A8, B80); PG8_MMA8(1, 1, A8, B81); } else { PG8_MMA(1, 0, At, B0); PG8_MMA(1, 1, At, B1); } PG8_BAR; PG8_SCHED;
        }
        if (PG8_ALIGN_EPI) { if (wr == 0) PG8_BAR; }
        if constexpr (FP8) asm volatile("s_nop 7\n\ts_nop 7\n\ts_nop 7\n\ts_nop 7" ::: "memory");
        { int t2 = threadIdx.x; asm volatile("" : "+v"(t2)); const int l2 = t2 & 63; run_epi(E, acc, cur, wr, wc, l2 & 15, l2 >> 4); }
        if (!has_next) break;
#pragma unroll
        for (int a = 0; a < 2; ++a)
#pragma unroll
            for (int b = 0; b < 2; ++b)
#pragma unroll
                for (int m = 0; m < 4; ++m)
#pragma unroll
                    for (int n = 0; n < 2; ++n) acc[a][b][m][n] = (f32x4){0.f, 0.f, 0.f, 0.f};
        if constexpr (FP8) {
#pragma unroll
            for (int a = 0; a < 2; ++a)
#pragma unroll
                for (int b = 0; b < 2; ++b)
#pragma unroll
                    for (int m = 0; m < 4; ++m)
#pragma unroll
                        for (int n = 0; n < 2; ++n) asm volatile("" : "+v"(acc[a][b][m][n]));
            asm volatile("s_nop 7\n\ts_nop 7" ::: "memory");
        }
        cur = nxt; ++ui;
        if constexpr (Sched::GATHER) {
#pragma unroll
            for (int h = 0; h < 2; ++h)
#pragma unroll
                for (int i = 0; i < 2; ++i) vA[h][i] = vAn[h][i]; }
        if (PG8_ALIGN_EPI) { if (wr == 1) PG8_BAR; }
    }
    PG8_WAIT_V(0);
    if (!PG8_ALIGN_EPI) { if (wr == 0) PG8_BAR; }
    PG8_BAR;
#undef PG8_SA
#undef PG8_SB
#undef PG8_STAGE
#undef PG8_LDA
#undef PG8_LDA8
#undef PG8_LDB8
#undef PG8_LD8
#undef PG8_LD8H
#undef PG8_MMA8
#undef PG8_LDB
#undef PG8_MMA
#undef PG8_WAIT_V
#undef PG8_WAIT_L
#undef PG8_BAR
#undef PG8_SCHED
}
}

#ifndef REPEAT_MASK
#define REPEAT_MASK 0
#endif
#define NREP(k) (((REPEAT_MASK >> (k)) & 1) ? 2 : 1)
#ifndef FASTMASK
#define FASTMASK 0x19A
#endif
template <int PH, class Epi, class Sched, int NSEG>
__device__ __forceinline__ void gemm_run(LAS unsigned char* lds, int lda, int ldb, int nt, const Sched& S, const Epi& E) {
    if constexpr ((FASTMASK >> PH) & 1) pg8::gemm_fast<Epi, Sched, NSEG>(lds, lda, ldb, nt, S, E);
    else gemm_simple<Epi, Sched, NSEG>(lda, ldb, nt, S, E);
}

struct Args { const float* in[24]; float* out; unsigned char* ws; int ph_lo, ph_hi; };
struct Ctx {
    LAS unsigned char* lds; volatile LAS unsigned* lw;
    GAS float* out; GAS unsigned char* ws; gu32* ctl;
    int tid, lane, wave, vcu, G, bid; float zf;
};

__device__ __forceinline__ void relaunder(Ctx& C) {
    int t = threadIdx.x; asm volatile("" : "+v"(t)); C.tid = t; C.lane = t & 63; C.wave = __builtin_amdgcn_readfirstlane(t >> 6);
    float z = 0.f; asm volatile("" : "+v"(z)); C.zf = z;
    asm volatile("" : "+s"(C.out), "+s"(C.ws), "+s"(C.ctl), "+s"(C.vcu), "+s"(C.G), "+s"(C.bid));
}
__device__ __forceinline__ void rms_row_to_bf16(const GAS float* xrow, const GAS float* gain, GAS bf16* orow, int lane, GAS unsigned char* orow8 = nullptr) {
    const GAS f32x4* xr = (const GAS f32x4*)xrow + lane; const GAS f32x4* gr = (const GAS f32x4*)gain + lane;
    f32x4 v[8]; float s = 0.f;
#pragma unroll
    for (int j = 0; j < 8; ++j) { v[j] = xr[64 * j]; s += (v[j].x * v[j].x + v[j].y * v[j].y) + (v[j].z * v[j].z + v[j].w * v[j].w); }
    const float rstd = 1.f / sqrtf(wave_sum(s, lane) * (1.f / D) + EPS);
    GAS unsigned long long* o8 = (GAS unsigned long long*)orow + lane;
#pragma unroll
    for (int j = 0; j < 8; ++j) { const f32x4 g = gr[64 * j];
        o8[64 * j] = (unsigned long long)pk2(v[j].x * rstd * g.x, v[j].y * rstd * g.y) | ((unsigned long long)pk2(v[j].z * rstd * g.z, v[j].w * rstd * g.w) << 32);
        if (orow8) ((GAS unsigned*)orow8)[64 * j + lane] = pk4_fp8(v[j].x * rstd * g.x, v[j].y * rstd * g.y, v[j].z * rstd * g.z, v[j].w * rstd * g.w); }
}
__device__ __forceinline__ void rms_row_from_bf16(const GAS bf16* xrow, const GAS float* gain, GAS bf16* orow, int lane, GAS unsigned char* orow8) {
    const GAS v4u* xr = (const GAS v4u*)xrow + lane; const GAS f32x4* gr = (const GAS f32x4*)gain + 2 * lane;
    v4u v[4]; float s = 0.f;
#pragma unroll
    for (int j = 0; j < 4; ++j) { v[j] = xr[64 * j]; const float a0 = bflo(v[j].x), a1 = bfhi(v[j].x), a2 = bflo(v[j].y), a3 = bfhi(v[j].y), a4 = bflo(v[j].z), a5 = bfhi(v[j].z), a6 = bflo(v[j].w), a7 = bfhi(v[j].w);
        s += ((a0 * a0 + a1 * a1) + (a2 * a2 + a3 * a3)) + ((a4 * a4 + a5 * a5) + (a6 * a6 + a7 * a7)); }
    const float rstd = 1.f / sqrtf(wave_sum(s, lane) * (1.f / D) + EPS);
#pragma unroll
    for (int j = 0; j < 4; ++j) { const f32x4 g0 = gr[128 * j] * rstd, g1 = gr[128 * j + 1] * rstd;
        const f32x4 a = (f32x4){bflo(v[j].x), bfhi(v[j].x), bflo(v[j].y), bfhi(v[j].y)} * g0, b = (f32x4){bflo(v[j].z), bfhi(v[j].z), bflo(v[j].w), bfhi(v[j].w)} * g1;
        ((GAS v4u*)orow)[64 * j + lane] = pack8(a, b);
        ((GAS v2u*)orow8)[64 * j + lane] = (v2u){pk4_fp8(a[0], a[1], a[2], a[3]), pk4_fp8(b[0], b[1], b[2], b[3])}; }
}
#ifndef LATE_PCT
#define LATE_PCT 2
#endif
struct WTile { const GAS float* W; GAS unsigned char* dst; int K, N, kind, rowmode, nsub, k0, n0; float sc; };
__device__ __forceinline__ void conv_tile_load(const WTile& t, f32x4 (&x)[16], int wave, int lane) {
    const GAS float* p = t.W + (size_t)(t.k0 + 16 * wave) * t.N + t.n0 + 4 * lane;
#pragma unroll
    for (int i = 0; i < 16; ++i) x[i] = *(const GAS f32x4*)(p + (size_t)i * t.N);
}
__device__ __forceinline__ void conv_tile_stage(const WTile& t, const f32x4 (&x)[16], LAS unsigned* L, int wave, int lane) {
    if (t.kind == 0) {
#pragma unroll
        for (int p = 0; p < 8; ++p)
#pragma unroll
            for (int e = 0; e < 4; ++e) L[(lane + 64 * e) * 65 + 8 * wave + p] = pk2(x[2 * p][e], x[2 * p + 1][e]);
    } else {
        const float sc = t.sc;
#pragma unroll
        for (int q = 0; q < 4; ++q)
#pragma unroll
            for (int e = 0; e < 4; ++e) L[(lane + 64 * e) * 33 + 4 * wave + q] = pk4_fp8(x[4 * q][e] * sc, x[4 * q + 1][e] * sc, x[4 * q + 2][e] * sc, x[4 * q + 3][e] * sc);
    }
}
__device__ __forceinline__ void conv_tile_store(const WTile& t, const LAS unsigned* L, int wave, int lane) {
    if (t.kind == 0) {
        const int c = lane & 15, rs = lane >> 4;
#pragma unroll 2
        for (int r = 0; r < 8; ++r) { const int np = 32 * wave + 4 * r + rs, n = 4 * (np & 63) + (np >> 6) + t.n0 - t.nsub;
            const LAS unsigned* p = L + np * 65 + 4 * c; v4u o; o.x = p[0]; o.y = p[1]; o.z = p[2]; o.w = p[3];
            *(GAS v4u*)(t.dst + ((size_t)n * t.K + t.k0) * 2 + 16 * c) = o; }
    } else {
        const int c = lane & 7, rs = lane >> 3;
#pragma unroll 2
        for (int r = 0; r < 4; ++r) { const int np = 32 * wave + 8 * r + rs; int n = 4 * (np & 63) + (np >> 6) + t.n0 - t.nsub;
            if (t.rowmode) n = 256 * (n >> 7) + (n & 127) + (t.rowmode == 2 ? 128 : 0);
            const LAS unsigned* p = L + np * 33 + 4 * c; v4u o; o.x = p[0]; o.y = p[1]; o.z = p[2]; o.w = p[3];
            *(GAS v4u*)(t.dst + (size_t)n * t.K + t.k0 + 16 * c) = o; }
    }
}
constexpr int WT_IN = (D / 128) * (NIN / 256), WT_MKV = (D / 128) * (2048 / 256), WT_BR = (1024 / 128) * (D / 256), WT_OUT = (D / 128) * (D / 256), WT_GU = (D / 128) * (DFF / 256), WT_DN = (DFF / 128) * (D / 256);
constexpr int WT_EARLY = WT_IN + WT_MKV, WT_ALL = WT_EARLY + 3 * WT_BR + WT_OUT + NEXP * (2 * WT_GU + WT_DN);
static_assert(MOE1_FP8 && MOE2_FP8, "the tile converter writes the expert weights as e4m3");
__device__ __forceinline__ void conv_tiles(Ctx& C, const CAS Args* A_, int layer, int tb, int te, int wg, int nwg) {
    LAS unsigned* L = (LAS unsigned*)C.lds;
    const GAS float* w_in = ((const GAS float*)A_->in[5]) + (size_t)layer * D * NIN;
    const GAS float* w_mkv = ((const GAS float*)A_->in[14]) + (size_t)layer * D * 2048;
    const GAS float* w_br = ((const GAS float*)A_->in[15]) + (size_t)layer * 3 * 1024 * D;
    const GAS float* w_out = ((const GAS float*)A_->in[16]) + (size_t)layer * D * D;
    const GAS float* w_g = ((const GAS float*)A_->in[21]) + (size_t)layer * NEXP * D * DFF;
    const GAS float* w_u = ((const GAS float*)A_->in[22]) + (size_t)layer * NEXP * D * DFF;
    const GAS float* w_d = ((const GAS float*)A_->in[23]) + (size_t)layer * NEXP * DFF * D;
    GAS unsigned char* ws = C.ws;
    auto decode = [&](int ti, WTile& t) {
        int r = ti, nbk;
        if (r >= WT_ALL) { r -= WT_ALL;
            const GAS float* w_in2 = w_in + (size_t)D * NIN; const GAS float* w_mkv2 = w_mkv + (size_t)D * 2048;
            if (r < WT_IN) { nbk = NIN / 256; const int nb = r % nbk; const bool f8 = nb >= 8; t = WTile{w_in2, ws + (f8 ? WS_WG8 : WS_WIN), D, NIN, f8 ? 1 : 0, 0, f8 ? 2048 : 0, 128 * (r / nbk), 256 * nb, WG8_SCALE}; return; } r -= WT_IN;
            nbk = 8; t = WTile{w_mkv2, ws + WS_WMKV, D, 2048, 0, 0, 0, 128 * (r / nbk), 256 * (r % nbk), 1.f}; return; }
        if (r < WT_IN) { nbk = NIN / 256; const int nb = r % nbk; const bool f8 = nb >= 8; t = WTile{w_in, ws + (f8 ? WS_WG8 : WS_WIN), D, NIN, f8 ? 1 : 0, 0, f8 ? 2048 : 0, 128 * (r / nbk), 256 * nb, WG8_SCALE}; return; } r -= WT_IN;
        if (r < WT_MKV) { nbk = 8; t = WTile{w_mkv, ws + WS_WMKV, D, 2048, 0, 0, 0, 128 * (r / nbk), 256 * (r % nbk), 1.f}; return; } r -= WT_MKV;
        if (r < 3 * WT_BR) { const int n = r / WT_BR; r -= n * WT_BR; nbk = 8; t = WTile{w_br + (size_t)n * 1024 * D, ws + WS_WBR + (n == 0 ? 0 : (size_t)(n + 1) * D * 1024), 1024, D, n == 0 ? 0 : 1, 0, 0, 128 * (r / nbk), 256 * (r % nbk), WBR8_SCALE}; return; } r -= 3 * WT_BR;
        if (r < WT_OUT) { nbk = 8; t = WTile{w_out, ws + WS_WOUT, D, D, layer == NLAYER - 1 ? 1 : 0, 0, 0, 128 * (r / nbk), 256 * (r % nbk), WOUT8_SCALE}; return; } r -= WT_OUT;
        if (r < NEXP * WT_GU) { const int e = r / WT_GU; r -= e * WT_GU; nbk = 2; t = WTile{w_g + (size_t)e * D * DFF, ws + WS_WGU + (size_t)e * 1024 * D, D, DFF, 1, 1, 0, 128 * (r / nbk), 256 * (r % nbk), WGU8_SCALE}; return; } r -= NEXP * WT_GU;
        if (r < NEXP * WT_GU) { const int e = r / WT_GU; r -= e * WT_GU; nbk = 2; t = WTile{w_u + (size_t)e * D * DFF, ws + WS_WGU + (size_t)e * 1024 * D, D, DFF, 1, 2, 0, 128 * (r / nbk), 256 * (r % nbk), WGU8_SCALE}; return; } r -= NEXP * WT_GU;
        { const int e = r / WT_DN; r -= e * WT_DN; nbk = 8; t = WTile{w_d + (size_t)e * DFF * D, ws + WS_WD + (size_t)e * D * DFF, DFF, D, 1, 0, 0, 128 * (r / nbk), 256 * (r % nbk), WD8_SCALE}; }
    };
    int ti = tb + wg; if (ti >= te) return;
    WTile cur, nxt; f32x4 x[16]; decode(ti, cur); conv_tile_load(cur, x, C.wave, C.lane);
    for (;;) {
        conv_tile_stage(cur, x, L, C.wave, C.lane);
        const int tn = ti + nwg; const bool has = tn < te;
        if (has) { decode(tn, nxt); conv_tile_load(nxt, x, C.wave, C.lane); }
        __syncthreads();
        conv_tile_store(cur, L, C.wave, C.lane);
        __syncthreads();
        if (!has) break;
        cur = nxt; ti = tn;
    }
}
__device__ __forceinline__ void phase_prep(Ctx& C, const CAS Args* A_, int layer, bool late, int gw, int NGW) {
    if (late) { conv_tiles(C, A_, layer, WT_EARLY, WT_ALL + (layer + 1 < NLAYER ? WT_EARLY : 0), C.vcu, C.G); return; }
    if (!LATE_PCT) conv_tiles(C, A_, layer, 0, WT_ALL, C.vcu, C.G);
    else if (layer == 0) conv_tiles(C, A_, layer, 0, WT_EARLY, C.vcu, C.G);
    GAS bf16* H = (GAS bf16*)(C.ws + WS_H); GAS bf16* MemH = (GAS bf16*)(C.ws + WS_MEMH);
    if (layer == 0) { const GAS float* xin = (const GAS float*)A_->in[0];
        for (int m = gw; m < T; m += NGW) rms_row_to_bf16(xin + (size_t)m * D, ((const GAS float*)A_->in[2]) + layer * D, H + (size_t)m * D, C.lane, (GAS unsigned char*)(C.ws + WS_H8) + (size_t)m * D); }
    else { const GAS bf16* xb = (const GAS bf16*)(C.ws + WS_XB);
        for (int m = gw; m < T; m += NGW) rms_row_from_bf16(xb + (size_t)m * D, ((const GAS float*)A_->in[2]) + layer * D, H + (size_t)m * D, C.lane, (GAS unsigned char*)(C.ws + WS_H8) + (size_t)m * D); }
    for (int m = gw; m < MEMT; m += NGW) rms_row_to_bf16(((const GAS float*)A_->in[1]) + (size_t)m * D, ((const GAS float*)A_->in[3]) + layer * D, MemH + (size_t)m * D, C.lane);
}

typedef float f32x4_t __attribute__((ext_vector_type(4)));
__device__ __forceinline__ bf16x8 ld_lds16(const LAS bf16* p) { return *(const LAS bf16x8*)p; }
__device__ __forceinline__ bf16x8 ld_lds8x2(const LAS bf16* p0, const LAS bf16* p1) {
    const v2u a = *(const LAS v2u*)p0, b = *(const LAS v2u*)p1; v4u w; w.x = a.x; w.y = a.y; w.z = b.x; w.w = b.y; return __builtin_bit_cast(bf16x8, w);
}
__device__ __forceinline__ float quad_sum(float v, int lane) { v += shx(v, 16, lane); v += shx(v, 32, lane); return v; }
__device__ __forceinline__ float quad_max(float v, int lane) { v = fmaxf(v, shx(v, 16, lane)); v = fmaxf(v, shx(v, 32, lane)); return v; }
#define MFMA16(a, b, c) __builtin_amdgcn_mfma_f32_16x16x32_bf16((a), (b), (c), 0, 0, 0)
typedef short v4i16_t __attribute__((ext_vector_type(4)));
__device__ __forceinline__ bf16x8 ld_tr2(const LAS bf16* base, int pitch, int rowA, int rowB, int col0, int lane) {
    const int q = (lane & 15) >> 2, p = lane & 3;
    const v4i16_t a = __builtin_amdgcn_ds_read_tr16_b64_v4i16((LAS v4i16_t*)(base + (rowA + q) * pitch + col0 + 4 * p));
    const v4i16_t b = __builtin_amdgcn_ds_read_tr16_b64_v4i16((LAS v4i16_t*)(base + (rowB + q) * pitch + col0 + 4 * p));
    bf16x8 r; r[0] = a[0]; r[1] = a[1]; r[2] = a[2]; r[3] = a[3]; r[4] = b[0]; r[5] = b[1]; r[6] = b[2]; r[7] = b[3]; return r;
}

constexpr int VA_PITCH = 144;
struct ARaw { unsigned xv[16]; f32x2 gv; f32x4 wf[4][2]; v2u uu[8]; float bt; };
__device__ __forceinline__ void mixer_a_load(Ctx& C, const CAS Args* A_, int layer, int unit, ARaw& R) {
    const int g = unit & 7, bn = unit >> 3;
    const GAS bf16* P1 = (const GAS bf16*)(C.ws + WS_P1);
    const GAS float* vgain = ((const GAS float*)A_->in[6]) + (layer * 8 + g) * 128; const GAS float* Wsp = ((const GAS float*)A_->in[7]) + (size_t)(layer * 8 + g) * 128 * 128; const GAS float* bsp = ((const GAS float*)A_->in[8]) + (layer * 8 + g) * 128;
    const int lane = C.lane, fr = lane & 15, fq = lane >> 4, w = C.wave, t = 16 * w + fr; const size_t row = (size_t)(bn * 128 + t);
#pragma unroll
    for (int i = 0; i < 16; ++i) R.xv[i] = *(const GAS unsigned*)(P1 + (size_t)(bn * 128 + 16 * w + i) * 2048 + 1024 + g * 128 + 2 * lane);
    R.gv = *(const GAS f32x2*)(vgain + 2 * lane);
#pragma unroll
    for (int ks = 0; ks < 4; ++ks) { R.wf[ks][0] = *(const GAS f32x4*)(Wsp + t * 128 + 32 * ks + 8 * fq); R.wf[ks][1] = *(const GAS f32x4*)(Wsp + t * 128 + 32 * ks + 8 * fq + 4); }
#pragma unroll
    for (int ct = 0; ct < 8; ++ct) R.uu[ct] = *(const GAS v2u*)(P1 + row * 2048 + g * 128 + 16 * ct + 4 * fq);
    R.bt = bsp[t];
}
__device__ __forceinline__ void mixer_a_compute(Ctx& C, int unit, const ARaw& R) {
    const int g = unit & 7, bn = unit >> 3;
    GAS bf16* Y = (GAS bf16*)(C.ws + WS_Y);
    LAS bf16* Vn = (LAS bf16*)C.lds;
    const int lane = C.lane, fr = lane & 15, fq = lane >> 4, w = C.wave;
    const int t = 16 * w + fr;
    const size_t row = (size_t)(bn * 128 + t);
    __syncthreads();
#pragma unroll
    for (int i = 0; i < 16; ++i) { const float a = bflo(R.xv[i]), b = bfhi(R.xv[i]);
        const float rstd = 1.f / sqrtf(wave_sum(a * a + b * b, lane) * (1.f / 128) + EPS);
        *(LAS unsigned*)(Vn + (16 * w + i) * VA_PITCH + 2 * lane) = pk2(a * rstd * R.gv[0], b * rstd * R.gv[1]); }
    __syncthreads();
    f32x4 acc[8];
#pragma unroll
    for (int ct = 0; ct < 8; ++ct) acc[ct] = (f32x4){C.zf, C.zf, C.zf, C.zf};
#pragma unroll
    for (int ks = 0; ks < 4; ++ks) {
        const int s0 = 32 * ks + 8 * fq; const f32x4 w0 = R.wf[ks][0], w1 = R.wf[ks][1];
        v4u wb; wb.x = pk2(s0 + 0 <= t ? w0[0] : 0.f, s0 + 1 <= t ? w0[1] : 0.f); wb.y = pk2(s0 + 2 <= t ? w0[2] : 0.f, s0 + 3 <= t ? w0[3] : 0.f);
        wb.z = pk2(s0 + 4 <= t ? w1[0] : 0.f, s0 + 5 <= t ? w1[1] : 0.f); wb.w = pk2(s0 + 6 <= t ? w1[2] : 0.f, s0 + 7 <= t ? w1[3] : 0.f);
        const bf16x8 bfrag = __builtin_bit_cast(bf16x8, wb);
        if (32 * ks <= 16 * w + 15) {
#pragma unroll
            for (int ct = 0; ct < 8; ++ct) acc[ct] = MFMA16(ld_tr2(Vn, VA_PITCH, 32 * ks + 8 * fq, 32 * ks + 8 * fq + 4, 16 * ct, lane), bfrag, acc[ct]); }
    }
    const float bt = R.bt;
#pragma unroll
    for (int ct = 0; ct < 8; ++ct) {
        const int c = 16 * ct + 4 * fq;
        v2u o; o.x = pk2(bflo(R.uu[ct].x) * (acc[ct][0] + bt), bfhi(R.uu[ct].x) * (acc[ct][1] + bt)); o.y = pk2(bflo(R.uu[ct].y) * (acc[ct][2] + bt), bfhi(R.uu[ct].y) * (acc[ct][3] + bt));
        *(GAS v2u*)(Y + row * 3072 + g * 128 + c) = o;
    }
}
constexpr int KB_PITCH = 72, VB_PITCH = 80;
struct BRaw { v4u qx[4][2]; v2u kx[8], vx[8]; float sink4[4]; };
struct BGain { f32x4 gq0[2], gq1[2], kg4; };
__device__ __forceinline__ void mixer_b_load(Ctx& C, const CAS Args* A_, int layer, int unit, BRaw& R) {
    const int hk = unit & 3, bn = unit >> 2, n = bn & 31;
    const GAS bf16* P2 = (const GAS bf16*)(C.ws + WS_P2);
    const GAS float* sinks = ((const GAS float*)A_->in[11]) + layer * 16;
    const int lane = C.lane, fr = lane & 15, fq = lane >> 4, w = C.wave, rg = lane >> 4, dc = lane & 15;
    const size_t row = (size_t)bn * 128 + 16 * w + fr;
#pragma unroll
    for (int qh = 0; qh < 4; ++qh)
#pragma unroll
        for (int ks = 0; ks < 2; ++ks) R.qx[qh][ks] = *(const GAS v4u*)(P2 + row * 1536 + (hk * 4 + qh) * 64 + 32 * ks + 8 * fq);
#pragma unroll
    for (int it = 0; it < 8; ++it) { const int kj = 32 * w + 4 * it + rg; const bool ok = (n > 0 || kj >= 128);
        const size_t r2 = ok ? (size_t)bn * 128 - 128 + kj : (size_t)bn * 128;
        R.kx[it] = *(const GAS v2u*)(P2 + r2 * 1536 + 1024 + hk * 64 + 4 * dc); R.vx[it] = *(const GAS v2u*)(P2 + r2 * 1536 + 1280 + hk * 64 + 4 * dc);
        if (!ok) { R.kx[it] = (v2u){0u, 0u}; R.vx[it] = (v2u){0u, 0u}; } }
#pragma unroll
    for (int qh = 0; qh < 4; ++qh) R.sink4[qh] = sinks[hk * 4 + qh];
}
__device__ __forceinline__ void mixer_b_gains(Ctx& C, const CAS Args* A_, int layer, BGain& G) {
    const GAS float* qg = ((const GAS float*)A_->in[9]) + layer * 64; const GAS float* kg = ((const GAS float*)A_->in[10]) + layer * 64; const int fq = C.lane >> 4, dc = C.lane & 15;
#pragma unroll
    for (int ks = 0; ks < 2; ++ks) { G.gq0[ks] = *(const GAS f32x4*)(qg + 32 * ks + 8 * fq); G.gq1[ks] = *(const GAS f32x4*)(qg + 32 * ks + 8 * fq + 4); }
    G.kg4 = *(const GAS f32x4*)(kg + 4 * dc);
}
__device__ __forceinline__ void mixer_b_compute(Ctx& C, const CAS Args* A_, int layer, int unit, BRaw& R, const BGain& G, bool has_next, int next_unit) {
    const int hk = unit & 3, bn = unit >> 2, n = bn & 31;
    GAS bf16* Y = (GAS bf16*)(C.ws + WS_Y);
    LAS bf16* Ks = (LAS bf16*)C.lds;
    LAS bf16* Vs = Ks + 256 * KB_PITCH;
    const int lane = C.lane, fr = lane & 15, fq = lane >> 4, w = C.wave;
    const int qi = 16 * w + fr; const size_t row = (size_t)bn * 128 + qi;
    bf16x8 qfa[4][2]; float sink4[4];
    {
        float gq[2][8];
#pragma unroll
        for (int ks = 0; ks < 2; ++ks)
#pragma unroll
            for (int e = 0; e < 4; ++e) { gq[ks][e] = G.gq0[ks][e]; gq[ks][4 + e] = G.gq1[ks][e]; }
#pragma unroll
        for (int qh = 0; qh < 4; ++qh) sink4[qh] = R.sink4[qh];
#pragma unroll
        for (int qh = 0; qh < 4; ++qh) {
            float qv[2][8]; float ss = 0.f;
#pragma unroll
            for (int ks = 0; ks < 2; ++ks) { const v4u x = R.qx[qh][ks];
                qv[ks][0] = bflo(x.x); qv[ks][1] = bfhi(x.x); qv[ks][2] = bflo(x.y); qv[ks][3] = bfhi(x.y); qv[ks][4] = bflo(x.z); qv[ks][5] = bfhi(x.z); qv[ks][6] = bflo(x.w); qv[ks][7] = bfhi(x.w);
#pragma unroll
                for (int e = 0; e < 8; ++e) ss += qv[ks][e] * qv[ks][e]; }
            const float qr = 0.125f / sqrtf(quad_sum(ss, lane) * (1.f / 64) + EPS);
#pragma unroll
            for (int ks = 0; ks < 2; ++ks) { v4u p;
                p.x = pk2(qv[ks][0] * qr * gq[ks][0], qv[ks][1] * qr * gq[ks][1]); p.y = pk2(qv[ks][2] * qr * gq[ks][2], qv[ks][3] * qr * gq[ks][3]);
                p.z = pk2(qv[ks][4] * qr * gq[ks][4], qv[ks][5] * qr * gq[ks][5]); p.w = pk2(qv[ks][6] * qr * gq[ks][6], qv[ks][7] * qr * gq[ks][7]); qfa[qh][ks] = __builtin_bit_cast(bf16x8, p); }
        }
    }
    __syncthreads();
    {
        const int rg = lane >> 4, dc = lane & 15;
        const f32x4 kg4 = G.kg4;
#pragma unroll
        for (int it = 0; it < 8; ++it) { const int kj = 32 * w + 4 * it + rg;
            const float a0 = bflo(R.kx[it].x), a1 = bfhi(R.kx[it].x), a2 = bflo(R.kx[it].y), a3 = bfhi(R.kx[it].y);
            float ss = (a0 * a0 + a1 * a1) + (a2 * a2 + a3 * a3);
            ss += shx(ss, 1, lane); ss += shx(ss, 2, lane); ss += shx(ss, 4, lane); ss += shx(ss, 8, lane);
            const float rstd = 1.f / sqrtf(ss * (1.f / 64) + EPS);
            v2u o; o.x = pk2(a0 * rstd * kg4[0], a1 * rstd * kg4[1]); o.y = pk2(a2 * rstd * kg4[2], a3 * rstd * kg4[3]);
            *(LAS v2u*)(Ks + kj * KB_PITCH + 4 * dc) = o; *(LAS v2u*)(Vs + kj * VB_PITCH + 4 * dc) = R.vx[it]; }
    }
    __syncthreads();
    if (has_next) mixer_b_load(C, A_, layer, next_unit, R);
#pragma unroll
    for (int qh = 0; qh < 4; ++qh) {
        const int h = hk * 4 + qh;
        int ldo = 0; asm volatile("" : "+v"(ldo));
        const LAS bf16* Ksl = Ks + ldo; const LAS bf16* Vsl = Vs + ldo;
        bf16x8 qf[2]; qf[0] = qfa[qh][0]; qf[1] = qfa[qh][1];
        f32x4 sc[9];
#pragma unroll
        for (int kt = 0; kt < 9; ++kt) { sc[kt] = (f32x4){C.zf, C.zf, C.zf, C.zf};
#pragma unroll
            for (int ks = 0; ks < 2; ++ks) sc[kt] = MFMA16(ld_lds16(Ksl + (16 * (w + kt) + fr) * KB_PITCH + 32 * ks + 8 * fq), qf[ks], sc[kt]); }
        const float sink = sink4[qh]; float mx = sink;
#pragma unroll
        for (int kt = 0; kt < 9; ++kt)
#pragma unroll
            for (int r = 0; r < 4; ++r) { const int kj = 16 * (w + kt) + 4 * fq + r; const bool ok = (kj > qi) && (kj <= qi + 128) && (n > 0 || kj >= 128);
                sc[kt][r] = ok ? sc[kt][r] : -3.0e38f; mx = fmaxf(mx, sc[kt][r]); }
        mx = quad_max(mx, lane); float l = 0.f;
#pragma unroll
        for (int kt = 0; kt < 9; ++kt)
#pragma unroll
            for (int r = 0; r < 4; ++r) { const float p = (sc[kt][r] > -1.0e38f) ? __expf(sc[kt][r] - mx) : 0.f; sc[kt][r] = p; l += p; }
        l = quad_sum(l, lane) + __expf(sink - mx);
        const float inv = 1.f / l;
        f32x4 oc[4];
#pragma unroll
        for (int dt = 0; dt < 4; ++dt) oc[dt] = (f32x4){C.zf, C.zf, C.zf, C.zf};
#pragma unroll
        for (int pr = 0; pr < 5; ++pr) {
            const int t0 = w + 2 * pr, t1r = w + 2 * pr + 1; const bool has1 = (2 * pr + 1) < 9; const int t1 = t1r > 15 ? 15 : t1r;
            v4u pb; pb.x = pk2(sc[2 * pr][0], sc[2 * pr][1]); pb.y = pk2(sc[2 * pr][2], sc[2 * pr][3]);
            if (has1) { pb.z = pk2(sc[has1 ? 2 * pr + 1 : 0][0], sc[has1 ? 2 * pr + 1 : 0][1]); pb.w = pk2(sc[has1 ? 2 * pr + 1 : 0][2], sc[has1 ? 2 * pr + 1 : 0][3]); } else { pb.z = 0u; pb.w = 0u; }
            const bf16x8 pfrag = __builtin_bit_cast(bf16x8, pb);
#pragma unroll
            for (int dt = 0; dt < 4; ++dt) oc[dt] = MFMA16(ld_tr2(Vsl, VB_PITCH, 16 * t0 + 4 * fq, 16 * t1 + 4 * fq, 16 * dt, lane), pfrag, oc[dt]);
        }
#pragma unroll
        for (int dt = 0; dt < 4; ++dt) { const float i8 = inv * YBC8_SCALE; unsigned ro = (unsigned)row * 6144u + (unsigned)(2048 + h * 64 + 4 * fq); asm volatile("" : "+v"(ro));
            *(GAS unsigned*)((GAS unsigned char*)Y + ro + 16 * dt) = pk4_fp8(oc[dt][0] * i8, oc[dt][1] * i8, oc[dt][2] * i8, oc[dt][3] * i8); }
    }
}
constexpr int KC_PITCH = 264, VC_PITCH = 272;
struct CRaw { v2u kx[16]; v4u qx[8]; };
__device__ __forceinline__ void mixer_c_load(Ctx& C, int unit, CRaw& R) {
    const int h = unit & 3, qt = unit >> 2, b = qt >> 5;
    const GAS bf16* P3 = (const GAS bf16*)(C.ws + WS_P3); const GAS bf16* KVM = (const GAS bf16*)(C.ws + WS_KVM);
    const int lane = C.lane, fr = lane & 15, fq = lane >> 4, w = C.wave; const size_t row = (size_t)qt * 128 + 16 * w + fr;
#pragma unroll
    for (int i = 0; i < 16; ++i) R.kx[i] = *(const GAS v2u*)(KVM + (size_t)(b * 256 + 32 * w + i) * 2048 + h * 256 + 4 * lane);
#pragma unroll
    for (int ks = 0; ks < 8; ++ks) R.qx[ks] = *(const GAS v4u*)(P3 + row * 1024 + h * 256 + 32 * ks + 8 * fq);
}
__device__ __forceinline__ void mixer_c_compute(Ctx& C, int unit, CRaw& R, f32x4 cg4, bool has_next, int next_unit) {
    const int h = unit & 3, qt = unit >> 2, b = qt >> 5;
    const GAS bf16* KVM = (const GAS bf16*)(C.ws + WS_KVM); GAS bf16* Y = (GAS bf16*)(C.ws + WS_Y);
    LAS bf16* KV = (LAS bf16*)C.lds;
    const int lane = C.lane, fr = lane & 15, fq = lane >> 4, w = C.wave;
    v2u kx2[16];
#pragma unroll
    for (int i = 0; i < 16; ++i) kx2[i] = *(const GAS v2u*)(KVM + (size_t)(b * 256 + 32 * w + 16 + i) * 2048 + h * 256 + 4 * lane);
    __syncthreads();
#pragma unroll
    for (int i = 0; i < 32; ++i) {
        const v2u kxi = i < 16 ? R.kx[i & 15] : kx2[i & 15];
        const float a0 = bflo(kxi.x), a1 = bfhi(kxi.x), a2 = bflo(kxi.y), a3 = bfhi(kxi.y);
        const float rstd = 1.f / sqrtf(wave_sum(a0 * a0 + a1 * a1 + a2 * a2 + a3 * a3, lane) * (1.f / 256) + EPS);
        v2u o; o.x = pk2(a0 * rstd * cg4[0], a1 * rstd * cg4[1]); o.y = pk2(a2 * rstd * cg4[2], a3 * rstd * cg4[3]);
        *(LAS v2u*)(KV + (32 * w + i) * KC_PITCH + 4 * lane) = o; if ((i & 7) == 7) asm volatile("" ::: "memory"); }
    __syncthreads();
    const size_t row = (size_t)qt * 128 + 16 * w + fr;
    bf16x8 pf[8];
    {
        bf16x8 qf[8];
        {
            float ss = 0.f;
#pragma unroll
            for (int ks = 0; ks < 8; ++ks) { const v4u x = R.qx[ks];
                const float e0 = bflo(x.x), e1 = bfhi(x.x), e2 = bflo(x.y), e3 = bfhi(x.y), e4 = bflo(x.z), e5 = bfhi(x.z), e6 = bflo(x.w), e7 = bfhi(x.w);
                ss += (e0 * e0 + e1 * e1) + (e2 * e2 + e3 * e3) + (e4 * e4 + e5 * e5) + (e6 * e6 + e7 * e7); }
            const float qr = 0.0625f / sqrtf(quad_sum(ss, lane) * (1.f / 256) + EPS);
#pragma unroll
            for (int ks = 0; ks < 8; ++ks) { const v4u x = R.qx[ks]; v4u p;
                p.x = pk2(bflo(x.x) * qr, bfhi(x.x) * qr); p.y = pk2(bflo(x.y) * qr, bfhi(x.y) * qr); p.z = pk2(bflo(x.z) * qr, bfhi(x.z) * qr); p.w = pk2(bflo(x.w) * qr, bfhi(x.w) * qr);
                qf[ks] = __builtin_bit_cast(bf16x8, p); }
        }
        f32x4 sc[16];
#pragma unroll
        for (int mt = 0; mt < 16; ++mt) { sc[mt] = (f32x4){C.zf, C.zf, C.zf, C.zf};
#pragma unroll
            for (int ks = 0; ks < 8; ++ks) sc[mt] = MFMA16(ld_lds16(KV + (16 * mt + fr) * KC_PITCH + 32 * ks + 8 * fq), qf[ks], sc[mt]);
            asm volatile("" ::: "memory"); }
        float mx = -3.0e38f;
#pragma unroll
        for (int mt = 0; mt < 16; ++mt) mx = fmaxf(fmaxf(mx, fmaxf(sc[mt][0], sc[mt][1])), fmaxf(sc[mt][2], sc[mt][3]));
        mx = quad_max(mx, lane); float l = 0.f;
#pragma unroll
        for (int mt = 0; mt < 16; ++mt)
#pragma unroll
            for (int r = 0; r < 4; ++r) { sc[mt][r] = __expf(sc[mt][r] - mx); l += sc[mt][r]; }
        const float inv = 1.f / quad_sum(l, lane);
#pragma unroll
        for (int pr = 0; pr < 8; ++pr) { v4u pb; pb.x = pk2(sc[2 * pr][0] * inv, sc[2 * pr][1] * inv); pb.y = pk2(sc[2 * pr][2] * inv, sc[2 * pr][3] * inv);
            pb.z = pk2(sc[2 * pr + 1][0] * inv, sc[2 * pr + 1][1] * inv); pb.w = pk2(sc[2 * pr + 1][2] * inv, sc[2 * pr + 1][3] * inv); pf[pr] = __builtin_bit_cast(bf16x8, pb); }
    }
    v2u vx[16], vx2[16];
#pragma unroll
    for (int i = 0; i < 16; ++i) { vx[i] = *(const GAS v2u*)(KVM + (size_t)(b * 256 + 32 * w + i) * 2048 + 1024 + h * 256 + 4 * lane); vx2[i] = *(const GAS v2u*)(KVM + (size_t)(b * 256 + 32 * w + 16 + i) * 2048 + 1024 + h * 256 + 4 * lane); }
    __syncthreads();
#pragma unroll
    for (int i = 0; i < 16; ++i) *(LAS v2u*)(KV + (32 * w + i) * VC_PITCH + 4 * lane) = vx[i];
#pragma unroll
    for (int i = 0; i < 16; ++i) *(LAS v2u*)(KV + (32 * w + 16 + i) * VC_PITCH + 4 * lane) = vx2[i];
    __syncthreads();
    if (has_next) mixer_c_load(C, next_unit, R);
#pragma unroll 4
    for (int dt = 0; dt < 16; ++dt) {
        f32x4 oc = (f32x4){C.zf, C.zf, C.zf, C.zf};
#pragma unroll
        for (int pr = 0; pr < 8; ++pr) oc = MFMA16(ld_tr2(KV, VC_PITCH, 32 * pr + 4 * fq, 32 * pr + 16 + 4 * fq, 16 * dt, lane), pf[pr], oc);
        asm volatile("" ::: "memory");
        unsigned ro = (unsigned)row * 6144u + (unsigned)(3072 + h * 256 + 4 * fq); asm volatile("" : "+v"(ro));
        *(GAS unsigned*)((GAS unsigned char*)Y + ro + 16 * dt) = pk4_fp8(oc[0] * YBC8_SCALE, oc[1] * YBC8_SCALE, oc[2] * YBC8_SCALE, oc[3] * YBC8_SCALE);
    }
}
__device__ __forceinline__ void phase_mix(Ctx& C, const CAS Args* A_, int layer, int conv_slot) {
    constexpr int NA = NB * 32 * 8, NBU = NB * 32 * 4, NC = (T / 128) * 4;
#ifndef MIXSEL
#define MIXSEL 7
#endif
#ifndef MIXREP
#define MIXREP 0
#endif
    if (conv_slot == 0) { __syncthreads(); phase_prep(C, A_, layer, true, C.vcu * NWAVES + C.wave, C.G * NWAVES); __syncthreads(); relaunder(C); asm volatile("" : "+s"(A_)); }
    for (int rp = 0; rp < ((MIXREP & 1) ? 2 : 1); ++rp) {
        int u = C.vcu; ARaw R0, R1; if (u < NA) mixer_a_load(C, A_, layer, u, R0);
        while (u < NA) { const int un = u + C.G; if (un < NA) mixer_a_load(C, A_, layer, un, R1); mixer_a_compute(C, u, R0); R0 = R1; u = un; } }
    if (conv_slot == 1) { __syncthreads(); phase_prep(C, A_, layer, true, C.vcu * NWAVES + C.wave, C.G * NWAVES); __syncthreads(); relaunder(C); asm volatile("" : "+s"(A_)); }
    for (int rp = 0; rp < ((MIXREP & 2) ? 2 : 1); ++rp) {
        int u = C.vcu; BRaw R0; BGain BG; mixer_b_gains(C, A_, layer, BG); if (u < NBU) mixer_b_load(C, A_, layer, u, R0);
        while (u < NBU) { const int un = u + C.G; mixer_b_compute(C, A_, layer, u, R0, BG, un < NBU, un); u = un; } }
    if (conv_slot == 2) { __syncthreads(); phase_prep(C, A_, layer, true, C.vcu * NWAVES + C.wave, C.G * NWAVES); __syncthreads(); relaunder(C); asm volatile("" : "+s"(A_)); }
    for (int rp = 0; rp < ((MIXREP & 4) ? 2 : 1); ++rp) {
        const GAS float* qg = ((const GAS float*)A_->in[12]) + layer * 256; const GAS float* kg = ((const GAS float*)A_->in[13]) + layer * 256;
        const f32x4 cg4 = *(const GAS f32x4*)(kg + 4 * C.lane) * *(const GAS f32x4*)(qg + 4 * C.lane);
        int u = C.vcu; CRaw R0; if (u < NC) mixer_c_load(C, u, R0);
        while (u < NC) { const int un = u + C.G; mixer_c_compute(C, u, R0, cg4, un < NC, un); u = un; } }
    __syncthreads();
}

__device__ __forceinline__ void phase_route(Ctx& C, const CAS Args* A_, int layer) {
    const GAS float* gain = ((const GAS float*)A_->in[4]) + layer * D; const GAS float* wrg = ((const GAS float*)A_->in[17]) + (size_t)layer * D * 4; const GAS float* brg = ((const GAS float*)A_->in[18]) + layer * 4;
    const GAS float* wre = ((const GAS float*)A_->in[19]) + (size_t)layer * D * 16; const GAS float* bre = ((const GAS float*)A_->in[20]) + layer * 16;
    GAS bf16* H = (GAS bf16*)(C.ws + WS_H); GAS int* perm2 = (GAS int*)(C.ws + WS_PERM2); GAS float* roww2 = (GAS float*)(C.ws + WS_ROWW2);
    GAS unsigned* cnt = (GAS unsigned*)C.ctl + CW_CNT + layer * 32;
    LAS float* part = (LAS float*)C.lds;
    LAS float* rs = part + 16 * 64 * 24;
    const int lane = C.lane, w = C.wave, kq = lane >> 4, j = lane & 15;
    for (int blk = C.vcu; blk < T / 64; blk += C.G) {
        const int t0 = blk * 64;
        __syncthreads();
#pragma unroll 1
        for (int hf = 0; hf < 2; ++hf) {
    const int kbase = 256 * w + 128 * hf;
    float Be[4][8], Bg[4][8]; f32x4 gs[4][2];
    const GAS f32x4* gp4 = (const GAS f32x4*)(gain + kbase + 8 * kq); const GAS float* wep1 = wre + (size_t)(kbase + 8 * kq) * 16 + j; const GAS float* wgp1 = wrg + (size_t)(kbase + 8 * kq) * 4 + (j & 3);
#pragma unroll
    for (int s = 0; s < 4; ++s) { const f32x4 g4a = gp4[0], g4b = gp4[1]; gs[s][0] = g4a; gs[s][1] = g4b;
#pragma unroll
        for (int e = 0; e < 4; ++e) { Be[s][e] = wep1[e * 16] * g4a[e]; Bg[s][e] = wgp1[e * 4] * g4a[e]; Be[s][4 + e] = wep1[(4 + e) * 16] * g4b[e]; Bg[s][4 + e] = wgp1[(4 + e) * 4] * g4b[e]; }
        gp4 += 8; wep1 += 512; wgp1 += 128; asm volatile("" : "+v"(gp4), "+v"(wep1), "+v"(wgp1)); }
    if (j >= 4) {
#pragma unroll
        for (int s = 0; s < 4; ++s)
#pragma unroll
            for (int e = 0; e < 8; ++e) Bg[s][e] = 0.f; }
#pragma unroll 1
        for (int tt = 0; tt < 4; ++tt) {
            const GAS bf16* xp = (const GAS bf16*)(C.ws + WS_XB) + (size_t)(t0 + 16 * tt + j) * D + kbase + 8 * kq; GAS unsigned char* hp = (GAS unsigned char*)(C.ws + WS_H8) + (size_t)(t0 + 16 * tt + j) * D + kbase + 8 * kq;
            f32x4 ae = (f32x4){C.zf, C.zf, C.zf, C.zf}, ag = (f32x4){C.zf, C.zf, C.zf, C.zf}; float ssq = 0.f;
            {
                v4u xr[4];
#pragma unroll
                for (int s = 0; s < 4; ++s) xr[s] = *(const GAS v4u*)(xp + 32 * s);
#pragma unroll
                for (int s = 0; s < 4; ++s) { const f32x4 xa = (f32x4){bflo(xr[s].x), bfhi(xr[s].x), bflo(xr[s].y), bfhi(xr[s].y)}, xb4 = (f32x4){bflo(xr[s].z), bfhi(xr[s].z), bflo(xr[s].w), bfhi(xr[s].w)};
                    ssq += ((xa[0] * xa[0] + xa[1] * xa[1]) + (xa[2] * xa[2] + xa[3] * xa[3])) + ((xb4[0] * xb4[0] + xb4[1] * xb4[1]) + (xb4[2] * xb4[2] + xb4[3] * xb4[3]));
                    const f32x4 ha = xa * gs[s][0], hb = xb4 * gs[s][1];
                    if (MOE1_FP8) *(GAS v2u*)(hp + 32 * s) = (v2u){pk4_fp8(ha[0], ha[1], ha[2], ha[3]), pk4_fp8(hb[0], hb[1], hb[2], hb[3])};
                    else *(GAS v4u*)(H + (size_t)(t0 + 16 * tt + j) * D + kbase + 8 * kq + 32 * s) = pack8(ha, hb);
#pragma unroll
                    for (int e = 0; e < 4; ++e) { ae = __builtin_amdgcn_mfma_f32_16x16x4f32(xa[e], Be[s][e], ae, 0, 0, 0); ag = __builtin_amdgcn_mfma_f32_16x16x4f32(xa[e], Bg[s][e], ag, 0, 0, 0); }
#pragma unroll
                    for (int e = 0; e < 4; ++e) { ae = __builtin_amdgcn_mfma_f32_16x16x4f32(xb4[e], Be[s][4 + e], ae, 0, 0, 0); ag = __builtin_amdgcn_mfma_f32_16x16x4f32(xb4[e], Bg[s][4 + e], ag, 0, 0, 0); } }
            }
            ssq += shx(ssq, 16, lane); ssq += shx(ssq, 32, lane);
            LAS float* pw = part + ((2 * w + hf) * 64 + 16 * tt) * 24;
#pragma unroll
            for (int r = 0; r < 4; ++r) { pw[(4 * kq + r) * 24 + j] = ae[r]; if (j < 4) pw[(4 * kq + r) * 24 + 16 + j] = ag[r]; }
            if (kq == 0) pw[j * 24 + 20] = ssq;
        }
        }
        __syncthreads();
        if (C.tid < 64) {
            const int t = t0 + C.tid;
            float lg[4], le[16]; float ssq = 0.f;
#pragma unroll
            for (int c = 0; c < 4; ++c) lg[c] = 0.f;
#pragma unroll
            for (int e = 0; e < 16; ++e) le[e] = 0.f;
#pragma unroll
            for (int ww = 0; ww < 16; ++ww) { const LAS float* p = part + (ww * 64 + C.tid) * 24;
#pragma unroll
                for (int e = 0; e < 16; ++e) le[e] += p[e];
#pragma unroll
                for (int c = 0; c < 4; ++c) lg[c] += p[16 + c];
                ssq += p[20]; }
            const float rstd = 1.f / sqrtf(ssq * (1.f / D) + EPS);
#pragma unroll
            for (int c = 0; c < 4; ++c) lg[c] = lg[c] * rstd + brg[c];
#pragma unroll
            for (int e = 0; e < 16; ++e) le[e] = le[e] * rstd + bre[e];
            int g = 0; float gm = lg[0];
#pragma unroll
            for (int c = 1; c < 4; ++c) if (lg[c] > gm) { gm = lg[c]; g = c; }
            float den = 0.f;
#pragma unroll
            for (int c = 0; c < 4; ++c) den += __expf(lg[c] - gm);
            const float pg = 1.f / den;
            float el[4] = {0.f, 0.f, 0.f, 0.f};
#pragma unroll
            for (int c = 0; c < 4; ++c)
#pragma unroll
                for (int jj = 0; jj < 4; ++jj) el[jj] = (c == g) ? le[4 * c + jj] : el[jj];
            int i1 = 0; float v1 = el[0];
#pragma unroll
            for (int jj = 1; jj < 4; ++jj) if (el[jj] > v1) { v1 = el[jj]; i1 = jj; }
            int i2 = (i1 == 0) ? 1 : 0; float v2 = el[i2];
#pragma unroll
            for (int jj = 0; jj < 4; ++jj) if (jj != i1 && el[jj] > v2) { v2 = el[jj]; i2 = jj; }
            const float e2 = __expf(v2 - v1); const float w1 = pg / (1.f + e2), w2 = pg * e2 / (1.f + e2);
            const int lo = i1 < i2 ? i1 : i2, hi = i1 < i2 ? i2 : i1; const float wlo = i1 < i2 ? w1 : w2, whi = i1 < i2 ? w2 : w1;
            const int pi = lo == 0 ? hi - 1 : (lo == 1 ? hi + 1 : 5);
            const int bucket = g * 6 + pi;
            int rank = 0, nsame = 1, leader = C.tid;
#pragma unroll 1
            for (int b = 0; b < NBUCKET; ++b) { const unsigned long long m = __builtin_amdgcn_ballot_w64(bucket == b);
                if (bucket == b) { rank = (int)__builtin_amdgcn_mbcnt_hi((unsigned)(m >> 32), __builtin_amdgcn_mbcnt_lo((unsigned)m, 0u)); nsame = __builtin_popcountll(m); leader = __builtin_ctzll(m); } }
            unsigned base = 0u; if (rank == 0) base = __hip_atomic_fetch_add(cnt + bucket, (unsigned)nsame, RLX_AGENT);
            base = (unsigned)__builtin_amdgcn_ds_bpermute(leader << 2, (int)base);
            const unsigned pos = base + (unsigned)rank; const size_t slot = (size_t)bucket * T + pos;
            perm2[slot] = t; *(GAS f32x4*)(roww2 + 4 * slot) = (f32x4){wlo, whi, rstd, 0.f};
        }
    }
}
__device__ __forceinline__ void moe_tables(Ctx& C, int layer) {
    GAS unsigned* cnt = (GAS unsigned*)C.ctl + CW_CNT + layer * 32;
    __syncthreads();
    if (C.tid < NBUCKET) C.lw[LW_CNT + C.tid] = __hip_atomic_load(cnt + C.tid, RLX_AGENT);
    __syncthreads();
    if (C.tid == 0) { unsigned acc = 0; for (int b = 0; b < NBUCKET; ++b) { C.lw[LW_TSTART + b] = acc; acc += (C.lw[LW_CNT + b] + 255u) >> 8; } C.lw[LW_TSTART + NBUCKET] = acc; C.lw[LW_NT] = acc; }
    __syncthreads();
}
constexpr int PH_PER_LAYER = 9, N_PHASES = NLAYER * PH_PER_LAYER;
template <int PMASK> __global__ void __launch_bounds__(NTHR, 2) fwd(Args args) {
    extern __shared__ __attribute__((aligned(16))) unsigned char lds_raw[];
    const CAS Args* ap = (const CAS Args*)__builtin_amdgcn_kernarg_segment_ptr();
    Ctx C;
    C.lds = (LAS unsigned char*)lds_raw; C.lw = (volatile LAS unsigned*)(C.lds + LDS_CTL_OFF);
    C.out = (GAS float*)args.out; C.ws = (GAS unsigned char*)args.ws; C.ctl = (gu32*)(args.ws + WS_CTL);
    C.tid = threadIdx.x; C.lane = C.tid & 63; C.wave = __builtin_amdgcn_readfirstlane(C.tid >> 6);
    C.G = gridDim.x; C.bid = blockIdx.x; { const int bx = blockIdx.x; C.vcu = (C.G % 8 == 0) ? (bx % 8) * (C.G / 8) + bx / 8 : bx; }
    C.zf = 0.f;
    for (int u = C.tid; u < (LDS_BYTES - LDS_CTL_OFF) / 4; u += NTHR) C.lw[u] = 0u;
    __syncthreads();
#if MEGA
    XcdBarrier bar = xcd_barrier_post((unsigned*)(args.ws + WS_CTL) + CW_BAR, C.lw + LW_BAR);
#define GRID_BAR() do { XcdBarrier b2_ = bar; asm volatile("" : "+s"(b2_.bar)); xcd_barrier(b2_); } while (0)
#else
#define GRID_BAR() do {} while (0)
#endif
    const int lo = args.ph_lo, hi = args.ph_hi;
#define IN(k) (((PMASK >> ((k) % PH_PER_LAYER)) & 1) && lo <= (k) && (k) < hi)
#define SEAM(k) do { if (IN(k) && IN((k) + 1)) GRID_BAR(); relaunder(C); asm volatile("" : "+s"(ap)); } while (0)
    for (int layer = 0; layer < NLAYER; ++layer) {
        const int p0 = layer * PH_PER_LAYER;
        if (IN(p0 + 0)) { for (int rep = 0; rep < NREP(0); ++rep) phase_prep(C, ap, layer, false, C.vcu * NWAVES + C.wave, C.G * NWAVES); } SEAM(p0 + 0);
        if (IN(p0 + 1)) { const GAS char* ws = (const GAS char*)C.ws;
            SchedInProj S{ws + WS_H, ws + WS_WIN, ws + WS_MEMH, ws + WS_WMKV, C.G, C.bid, 0};
            EpiInProj E{(GAS bf16*)(C.ws + WS_P1), (GAS bf16*)(C.ws + WS_P2), (GAS bf16*)(C.ws + WS_P3), (GAS bf16*)(C.ws + WS_P4), (GAS bf16*)(C.ws + WS_KVM)};
            for (int rep = 0; rep < NREP(1); ++rep) gemm_run<1, EpiInProj, SchedInProj, 1>(C.lds, D * 2, D * 2, D / 64, S, E);
            __syncthreads();
            {
                EpiGate EG{(GAS unsigned char*)(C.ws + WS_P4), (GAS bf16*)(C.ws + WS_P2), (GAS bf16*)(C.ws + WS_P3)};
                const int rem1 = (64 * 8 + 4 * 8) % C.G;
                { SchedGate SG{ws + WS_H8, ws + WS_WG8, C.G, C.bid, rem1, 0, 1 << 20}; pg8::gemm_fast<EpiGate, SchedGate, 1, true>(C.lds, D, D, D / 128, SG, EG); }
            }
        } SEAM(p0 + 1);
        if (IN(p0 + 2)) { for (int rep = 0; rep < NREP(2); ++rep) phase_mix(C, ap, layer, LATE_PCT == 2 ? (C.bid % 3) : -1); } SEAM(p0 + 2);
        if (IN(p0 + 3)) { const GAS char* ws = (const GAS char*)C.ws;
            for (int rep = 0; rep < NREP(3); ++rep) {
                { SchedMerge S{ws + WS_Y, ws + WS_WBR, C.G, C.bid};
                  EpiMerge E{(const GAS unsigned char*)(C.ws + WS_P4), (GAS bf16*)(C.ws + WS_MF), (GAS bf16*)(C.ws + WS_H), 1.f / 255.f, layer == NLAYER - 1 ? 1 : 0};
                  gemm_run<3, EpiMerge, SchedMerge, 1>(C.lds, 6144, 1024 * 2, 1024 / 64, S, E); }
                __syncthreads();
                { SchedMerge8 S{ws + WS_Y, ws + WS_WBR, C.G, C.bid};
                  EpiMerge E{(const GAS unsigned char*)(C.ws + WS_P4), (GAS bf16*)(C.ws + WS_MF), (GAS bf16*)(C.ws + WS_H), 1.f / (255.f * YBC8_SCALE * WBR8_SCALE), layer == NLAYER - 1 ? 1 : 0};
                  pg8::gemm_fast<EpiMerge, SchedMerge8, 1, true>(C.lds, 6144, 1024, 1024 / 128, S, E); }
            }
        } SEAM(p0 + 3);
        if (IN(p0 + 4)) { const GAS char* ws = (const GAS char*)C.ws;
            if (layer == NLAYER - 1) {
                SchedOut S{ws + WS_H8, ws + WS_WOUT, C.G, C.bid, 1};
                EpiOut E{(const GAS float*)ap->in[0], (GAS bf16*)(C.ws + WS_XB), layer == 0 ? 1 : 0, 1.f / (MRG8_SCALE * WOUT8_SCALE)};
                pg8::gemm_fast<EpiOut, SchedOut, 1, true>(C.lds, D, D, D / 128, S, E);
            } else {
                SchedOut S{ws + WS_H, ws + WS_WOUT, C.G, C.bid, 2};
                EpiOut E{(const GAS float*)ap->in[0], (GAS bf16*)(C.ws + WS_XB), layer == 0 ? 1 : 0, 1.f};
                gemm_run<4, EpiOut, SchedOut, 1>(C.lds, D * 2, D * 2, D / 64, S, E);
            }
        } SEAM(p0 + 4);
        if (IN(p0 + 5)) { phase_route(C, ap, layer); } SEAM(p0 + 5);
        if (IN(p0 + 7)) { const GAS char* ws = (const GAS char*)C.ws;
            moe_tables(C, layer);
            SchedMoe1 S{ws + (MOE1_FP8 ? WS_H8 : WS_H), ws + WS_WGU, (const GAS int*)(C.ws + WS_PERM2), C.lw, C.G, C.vcu};
            EpiMoe1 E{(const GAS float*)(C.ws + WS_ROWW2), (GAS bf16*)(C.ws + WS_HID)};
            for (int rep = 0; rep < NREP(7); ++rep) { if constexpr (MOE1_FP8) pg8::gemm_fast<EpiMoe1, SchedMoe1, 1, true>(C.lds, D, D, D / 128, S, E); else pg8::gemm_fast<EpiMoe1, SchedMoe1, 1, false>(C.lds, D * 2, D * 2, D / 64, S, E); }
        } SEAM(p0 + 7);
        if (IN(p0 + 8)) { const GAS char* ws = (const GAS char*)C.ws;
            moe_tables(C, layer);
            SchedMoe2 S{ws + WS_HID, ws + WS_WD, C.lw, C.G, C.vcu};
            EpiMoe2 E{(const GAS int*)(C.ws + WS_PERM2), (GAS bf16*)(C.ws + WS_XB), C.out, layer == NLAYER - 1 ? 1 : 0};
            if constexpr (MOE2_FP8) pg8::gemm_fast<EpiMoe2, SchedMoe2, 2, true>(C.lds, 1024, DFF, DFF / 128, S, E);
            else pg8::gemm_fast<EpiMoe2, SchedMoe2, 2, false>(C.lds, 1024 * 2, DFF * 2, DFF / 64, S, E);
        } SEAM(p0 + 8);
    }
#undef IN
#undef SEAM
}

#ifdef TESTMASK
template __global__ void fwd<TESTMASK>(Args);
#else
extern "C" void kernel_launch(void* const* d_in, const int* in_sizes, int n_in, void* d_out, int out_size, void* d_ws, size_t ws_size, hipStream_t stream) {
    static int grid = 0;
    if (grid == 0) {
        if (n_in != 24 || in_sizes[0] != T * D || out_size != T * D || ws_size < WS_END) { fprintf(stderr, "kernel_launch: unexpected shapes / workspace (n_in %d, ws %zu < %zu)\n", n_in, ws_size, (size_t)WS_END); grid = -1; return; }
        int dev = 0, cus = 0, per_cu = 0;
        if (hipGetDevice(&dev) != hipSuccess || hipDeviceGetAttribute(&cus, hipDeviceAttributeMultiprocessorCount, dev) != hipSuccess) { grid = -1; return; }
#if MEGA
        const void* fns[1] = {(const void*)fwd<0x1FF>};
#else
        const void* fns[9] = {(const void*)fwd<1>, (const void*)fwd<2>, (const void*)fwd<4>, (const void*)fwd<8>, (const void*)fwd<16>, (const void*)fwd<32>, (const void*)fwd<64>, (const void*)fwd<128>, (const void*)fwd<256>};
#endif
        for (const void* fn : fns) {
            if (hipFuncSetAttribute(fn, hipFuncAttributeMaxDynamicSharedMemorySize, LDS_BYTES) != hipSuccess) { fprintf(stderr, "kernel_launch: hipFuncSetAttribute failed\n"); grid = -1; return; }
            if (hipOccupancyMaxActiveBlocksPerMultiprocessor(&per_cu, fn, NTHR, LDS_BYTES) != hipSuccess || per_cu < 1) fprintf(stderr, "kernel_launch: occupancy query reports %d\n", per_cu);
        }
        (void)hipGetLastError();
        grid = cus;
    }
    if (grid < 0) return;
    if (hipMemsetAsync((char*)d_ws + WS_CTL, 0, CTL_ZERO_BYTES, stream) != hipSuccess) return;
    Args a{};
    for (int i = 0; i < 24; ++i) a.in[i] = (const float*)d_in[i];
    a.out = (float*)d_out; a.ws = (unsigned char*)d_ws;
#if MEGA
    a.ph_lo = 0; a.ph_hi = N_PHASES;
    hipLaunchKernelGGL(fwd<0x1FF>, dim3(grid), dim3(NTHR), LDS_BYTES, stream, a);
#else
    for (int p = 0; p < N_PHASES; ++p) {
        a.ph_lo = p; a.ph_hi = p + 1; const int k = p % PH_PER_LAYER;
        switch (k) {
        case 0: hipLaunchKernelGGL(fwd<1>, dim3(grid), dim3(NTHR), LDS_BYTES, stream, a); break;
        case 1: hipLaunchKernelGGL(fwd<2>, dim3(grid), dim3(NTHR), LDS_BYTES, stream, a); break;
        case 2: hipLaunchKernelGGL(fwd<4>, dim3(grid), dim3(NTHR), LDS_BYTES, stream, a); break;
        case 3: hipLaunchKernelGGL(fwd<8>, dim3(grid), dim3(NTHR), LDS_BYTES, stream, a); break;
        case 4: hipLaunchKernelGGL(fwd<16>, dim3(grid), dim3(NTHR), LDS_BYTES, stream, a); break;
        case 5: hipLaunchKernelGGL(fwd<32>, dim3(grid), dim3(NTHR), LDS_BYTES, stream, a); break;
        case 6: hipLaunchKernelGGL(fwd<64>, dim3(grid), dim3(NTHR), LDS_BYTES, stream, a); break;
        case 7: hipLaunchKernelGGL(fwd<128>, dim3(grid), dim3(NTHR), LDS_BYTES, stream, a); break;
        default: hipLaunchKernelGGL(fwd<256>, dim3(grid), dim3(NTHR), LDS_BYTES, stream, a); break;
        }
    }
#endif
}
#endif
```
